# Optimizing an MI355X kernel written in HIP

```python
import math
import jax, jax.numpy as jnp
from jax import lax
import numpy as np

D_MODEL = 1024
BATCH = 16
SEQ = 2048
DEPTH = 4

CHUNK = 64
N_MIXERS = 2
RET_HEADS = 4
RET_QK_DIM = 256
RET_V_DIM = 512
RET_IN = 2 * RET_HEADS * RET_QK_DIM + 2 * RET_HEADS * RET_V_DIM
SB_HEADS = 16
SB_HEAD_DIM = D_MODEL // SB_HEADS
SB_QBLOCK = 128
FFN_HIDDEN = -(-(8 * D_MODEL) // (3 * 256)) * 256
ROPE_THETA = 10000.0
EPS = 1e-6
N_RET = (DEPTH + 1) // 2
N_SB = DEPTH // 2

kernel_name = "hybrid_retention_stickbreaking_trunk"


def rms_norm(x, gain):
    xf = x.astype(jnp.float32)
    y = xf * lax.rsqrt(jnp.mean(xf * xf, axis=-1, keepdims=True) + EPS)
    return (y * gain.astype(jnp.float32)).astype(x.dtype)


def rotary(x, positions):
    d = x.shape[-1]
    inv_freq = 1.0 / (ROPE_THETA ** (jnp.arange(0, d // 2, dtype=jnp.float32) / (d // 2)))
    ang = positions.astype(jnp.float32)[:, None] * inv_freq[None, :]
    cos = jnp.cos(ang)[None, :, None, :].astype(x.dtype)
    sin = jnp.sin(ang)[None, :, None, :].astype(x.dtype)
    x1, x2 = x[..., : d // 2], x[..., d // 2:]
    return jnp.concatenate([x1 * cos - x2 * sin, x1 * sin + x2 * cos], axis=-1)


def retention(h, w_in, out_gain, w_o):
    B, S, _ = h.shape
    H, DK, DV, C = RET_HEADS, RET_QK_DIM, RET_V_DIM, CHUNK
    N = S // C
    proj = h @ w_in
    q, k, v, g = jnp.split(proj, [H * DK, 2 * H * DK, 2 * H * DK + H * DV], axis=-1)
    pos = jnp.arange(S)
    q = rotary(q.reshape(B, S, H, DK), pos)
    k = rotary(k.reshape(B, S, H, DK), pos) * (DK ** -0.5)
    v = v.reshape(B, S, H, DV)
    to_chunks = lambda t: t.reshape(B, N, C, H, t.shape[-1]).transpose(1, 0, 3, 2, 4)
    qc, kc, vc = to_chunks(q), to_chunks(k), to_chunks(v)

    log_gamma = jnp.log(1.0 - 2.0 ** (-5.0 - jnp.arange(H, dtype=jnp.float32)))
    idx = jnp.arange(C, dtype=jnp.float32)
    intra = jnp.exp(log_gamma[:, None, None] * jnp.abs(idx[:, None] - idx[None, :])).astype(q.dtype)
    q_decay = jnp.exp(log_gamma[:, None] * (idx + 1.0)).astype(q.dtype)
    k_decay = jnp.exp(log_gamma[:, None] * (C - 1.0 - idx)).astype(q.dtype)
    chunk_decay = jnp.exp(log_gamma * C).astype(q.dtype)

    scores = jnp.einsum('nbhcd,nbhed->nbhce', qc, kc) * intra
    inner = jnp.einsum('nbhce,nbhev->nbhcv', scores, vc)

    def step(state, xs):
        qn, kn, vn = xs
        cross = jnp.einsum('bhcd,bhdv->bhcv', qn * q_decay[None, :, :, None], state)
        new_state = state * chunk_decay[None, :, None, None] + jnp.einsum(
            'bhcd,bhcv->bhdv', kn * k_decay[None, :, :, None], vn)
        return new_state, cross

    state0 = jnp.zeros((B, H, DK, DV), dtype=q.dtype)
    _, cross = lax.scan(step, state0, (qc, kc, vc))
    o = (inner + cross).transpose(1, 0, 3, 2, 4).reshape(B, S, H, DV)
    o = rms_norm(o, out_gain)
    o = o.reshape(B, S, H * DV) * jax.nn.silu(g)
    return o @ w_o


def stick_breaking(h, w_in, q_gain, k_gain, w_o):
    B, S, _ = h.shape
    H, DH, QB = SB_HEADS, SB_HEAD_DIM, SB_QBLOCK
    q, k, v = jnp.split(h @ w_in, 3, axis=-1)
    heads = lambda t: t.reshape(B, S, H, DH).transpose(0, 2, 1, 3)
    q = rms_norm(heads(q), q_gain)
    k = rms_norm(heads(k), k_gain)
    v = heads(v)
    scale = DH ** -0.5
    outs = []
    for blk in range(S // QB):
        t0 = blk * QB
        kend = t0 + QB
        z = jnp.einsum('bhtd,bhsd->bhts', q[:, :, t0:kend], k[:, :, :kend]).astype(jnp.float32) * scale
        t_pos = t0 + jnp.arange(QB)
        s_pos = jnp.arange(kend)
        mask = s_pos[None, :] < t_pos[:, None]
        log_stay = jnp.where(mask, jax.nn.log_sigmoid(-z), 0.0)
        later = lax.cumsum(log_stay, axis=3, reverse=True) - log_stay
        weight = jnp.where(mask, jnp.exp(jax.nn.log_sigmoid(z) + later), 0.0)
        outs.append(jnp.einsum('bhts,bhsd->bhtd', weight.astype(v.dtype), v[:, :, :kend]))
    o = jnp.concatenate(outs, axis=2).transpose(0, 2, 1, 3).reshape(B, S, H * DH)
    return o @ w_o


def swiglu(h, w_in, w_out):
    gate, up = jnp.split(h @ w_in, 2, axis=-1)
    return (jax.nn.silu(gate) * up) @ w_out


def setup_inputs(seed: int = 0) -> dict:
    key = jax.random.key(seed)
    ks = jax.random.split(key, 12)
    nrm = lambda k, shape, fan_in: jax.random.normal(k, shape, jnp.float32) * (fan_in ** -0.5)
    gain = lambda k, shape: 1.0 + 0.02 * jax.random.normal(k, shape, jnp.float32)
    return {
        "x": jax.random.normal(ks[0], (BATCH, SEQ, D_MODEL), jnp.float32),
        "mix_norm": gain(ks[1], (DEPTH, D_MODEL)),
        "ffn_norm": gain(ks[2], (DEPTH, D_MODEL)),
        "ret_w_in": nrm(ks[3], (N_RET, D_MODEL, RET_IN), D_MODEL),
        "ret_out_norm": gain(ks[4], (N_RET, RET_HEADS, RET_V_DIM)),
        "ret_w_o": nrm(ks[5], (N_RET, RET_HEADS * RET_V_DIM, D_MODEL), RET_HEADS * RET_V_DIM),
        "sb_w_in": nrm(ks[6], (N_SB, D_MODEL, 3 * D_MODEL), D_MODEL),
        "sb_q_norm": gain(ks[7], (N_SB, SB_HEAD_DIM)),
        "sb_k_norm": gain(ks[8], (N_SB, SB_HEAD_DIM)),
        "sb_w_o": nrm(ks[9], (N_SB, D_MODEL, D_MODEL), D_MODEL),
        "ffn_w_in": nrm(ks[10], (DEPTH, D_MODEL, 2 * FFN_HIDDEN), D_MODEL),
        "ffn_w_out": nrm(ks[11], (DEPTH, FFN_HIDDEN, D_MODEL), FFN_HIDDEN),
    }


def reference(x, mix_norm, ffn_norm, ret_w_in, ret_out_norm, ret_w_o,
              sb_w_in, sb_q_norm, sb_k_norm, sb_w_o, ffn_w_in, ffn_w_out):
    for i in range(DEPTH):
        h = rms_norm(x, mix_norm[i])
        j = i // N_MIXERS
        if i % N_MIXERS == 0:
            x = x + retention(h, ret_w_in[j], ret_out_norm[j], ret_w_o[j])
        else:
            x = x + stick_breaking(h, sb_w_in[j], sb_q_norm[j], sb_k_norm[j], sb_w_o[j])
        x = x + swiglu(rms_norm(x, ffn_norm[i]), ffn_w_in[i], ffn_w_out[i])
    return x
```

```cpp
#include <hip/hip_runtime.h>
#include <hip/hip_cooperative_groups.h>
#include <cstdio>
#include <cstdint>
namespace cg = cooperative_groups;
constexpr int MTOK = 32768, DM = 1024, SEQ = 2048, FFH = 2816;
constexpr float EPSN = 1e-6f;
constexpr float C2SB = 0.125f * 1.4426950408889634f;
__device__ __forceinline__ int opaque_tid() { int t = threadIdx.x; asm volatile("" : "+v"(t)); return t; }
namespace pg8 {
#define PG8_LAS __attribute__((address_space(3)))
typedef unsigned short bf16_t;
typedef short bf16x8 __attribute__((ext_vector_type(8)));
typedef float f32x4 __attribute__((ext_vector_type(4)));
typedef unsigned u32x4 __attribute__((ext_vector_type(4)));
constexpr int BM = 256, BK = 64, HALF = 128, HTB = HALF * BK * 2  , STAGE_BYTES = 8 * HTB, NXCD = 8, WGM = 8;

__host__ __device__ __forceinline__ int lds_byte(int r, int c) { const int st = (r >> 4) * 2 + (c >> 5), rr = r & 15, cc = c & 31, ob = rr * 64 + cc * 2; return st * 1024 + (ob ^ (((ob >> 9) & 1) << 5)); }
__host__ __device__ __forceinline__ void stage_rc(int b, int& R, int& C) { const int st = b / 1024, sb = b % 1024, swz = sb ^ (((sb >> 9) & 1) << 5); R = (st >> 1) * 16 + swz / 64; C = (st & 1) * 32 + (swz % 64) / 2; }
__host__ __device__ __forceinline__ int perm32(int rho) { const int n = rho >> 4, i = rho & 15; return 8 * (i >> 2) + 4 * n + (i & 3); }

struct Unit { int pm, pn; };
struct Gemm { const bf16_t* A; const bf16_t* Bt; int M, N, K; };

struct StaticOrder {
    int nM, nN, nwg, G, c;
    __host__ __device__ void init(int M, int N, int G_, int c_) { nM = M / BM; nN = N / BM; nwg = nM * nN; G = G_; c = c_; }
    __host__ __device__ bool next(int i, Unit& u) const {
        const long L = (long)i * G + c; if (L >= nwg) return false;
        int wgid = (int)L; { const int q = nwg / NXCD, r = nwg % NXCD, xcd = wgid % NXCD, off = wgid / NXCD; wgid = (xcd < r ? xcd * (q + 1) : r * (q + 1) + (xcd - r) * q) + off; }
        const int nig = WGM * nN, gid = wgid / nig, fm = gid * WGM, gsz = (nM - fm) < WGM ? (nM - fm) : WGM;
        u.pm = fm + ((wgid % nig) % gsz); u.pn = (wgid % nig) / gsz; return true;
    }
    __device__ __forceinline__ void a_ready(const Unit&) const {}
    __device__ __forceinline__ void done(const Unit&) const {}
};

__device__ __forceinline__ unsigned cvt_pk_bf16(float lo, float hi) { unsigned r; asm volatile("v_cvt_pk_bf16_f32 %0, %1, %2" : "=v"(r) : "v"(lo), "v"(hi)); return r; }
template <class Epi, class Sched, bool ALIGN_EPI = false, bool SP2 = false>
__device__ __forceinline__ void gemm_phase(PG8_LAS unsigned char* lds, const Gemm g, const Sched& S, const Epi& E) {
    const int tid = opaque_tid(), wid = __builtin_amdgcn_readfirstlane(tid >> 6), lane = tid & 63, wr = wid >> 2, wc = wid & 3, fr = lane & 15, fq = lane >> 4;
    const int K = g.K, nt = K / BK;
    unsigned voffA[2], voffB[2];
#pragma unroll
    for (int i = 0; i < 2; ++i) { int R, C; stage_rc(tid * 16 + i * 8192, R, C); const int Rb = Epi::PERM ? ((R & ~31) + perm32(R & 31)) : R;
        voffA[i] = (unsigned)(R * K + C) * 2u; voffB[i] = (unsigned)(Rb * K + C) * 2u; }
    const size_t kstep = (size_t)(BK * 2);
    const size_t hstep = (size_t)HALF * K * 2;
    const size_t tstep = 2 * hstep;
    const unsigned ldsw = (unsigned)wid * 1024u;
    const int aoff = lds_byte(wr * 64 + fr, fq * 8), boff = lds_byte(wc * 32 + fr, fq * 8);
#define PG8_SA(b, h) (((b) * 2 + (h)) * HTB)
#define PG8_SB(b, h) ((4 + (b) * 2 + (h)) * HTB)
#define PG8_STAGE(bufoff, gbase, voff) do { _Pragma("unroll") for (int _i = 0; _i < 2; ++_i) \
        __builtin_amdgcn_global_load_lds((const unsigned*)((const char*)(gbase) + (voff)[_i]), (PG8_LAS unsigned*)(lds + (bufoff) + ldsw + _i * 8192), 16, 0, 0); } while (0)
#define PG8_LDA(dst, b, h) do { _Pragma("unroll") for (int m = 0; m < 4; ++m) _Pragma("unroll") for (int k = 0; k < 2; ++k) dst[m][k] = *(const PG8_LAS bf16x8*)(lds + PG8_SA(b, h) + aoff + m * 2048 + k * 1024); } while (0)
#define PG8_LDB(dst, b, h) do { _Pragma("unroll") for (int n = 0; n < 2; ++n) _Pragma("unroll") for (int k = 0; k < 2; ++k) dst[n][k] = *(const PG8_LAS bf16x8*)(lds + PG8_SB(b, h) + boff + n * 2048 + k * 1024); } while (0)
#define PG8_MMA(ai, bj, At, Bt) do { __builtin_amdgcn_s_setprio(1); _Pragma("unroll") for (int m = 0; m < 4; ++m) _Pragma("unroll") for (int n = 0; n < 2; ++n) _Pragma("unroll") for (int k = 0; k < 2; ++k) \
        acc[ai][bj][m][n] = __builtin_amdgcn_mfma_f32_16x16x32_bf16(Bt[n][k], At[m][k], acc[ai][bj][m][n], 0, 0, 0); __builtin_amdgcn_s_setprio(0); } while (0)
#define PG8_WAIT_V(n) asm volatile("s_waitcnt vmcnt(" #n ")" ::: "memory")
#define PG8_WAIT_L(n) asm volatile("s_waitcnt lgkmcnt(" #n ")" ::: "memory")
#define PG8_BAR __builtin_amdgcn_s_barrier()
#define PG8_SCHED __builtin_amdgcn_sched_barrier(0)
    Unit cur, nxt; int ui = 0;
    float rowc[8]; int rowc_pm = -1;
#pragma unroll
    for (int q = 0; q < 8; ++q) rowc[q] = 0.f;
    if (!S.next(0, cur)) return;
    f32x4 acc[2][2][4][2];
#pragma unroll
    for (int a = 0; a < 2; ++a)
#pragma unroll
        for (int b = 0; b < 2; ++b)
#pragma unroll
            for (int m = 0; m < 4; ++m)
#pragma unroll
                for (int n = 0; n < 2; ++n) acc[a][b][m][n] = (f32x4){0.f, 0.f, 0.f, 0.f};
    bf16x8 At[4][2], B0[2][2], B1[2][2];
    const char* cA = (const char*)g.A + (size_t)cur.pm * tstep; const char* cB = (const char*)g.Bt + (size_t)cur.pn * tstep;
    S.a_ready(cur);
    if constexpr (SP2) {
        PG8_STAGE(PG8_SB(0, 0), cB, voffB); PG8_STAGE(PG8_SB(0, 1), cB + hstep, voffB); PG8_STAGE(PG8_SA(0, 0), cA, voffA); PG8_STAGE(PG8_SA(0, 1), cA + hstep, voffA);
        if (wr == 1) PG8_BAR;
        PG8_WAIT_V(2); PG8_BAR;
        PG8_STAGE(PG8_SB(1, 0), cB + kstep, voffB); PG8_STAGE(PG8_SA(1, 0), cA + kstep, voffA); PG8_STAGE(PG8_SB(1, 1), cB + hstep + kstep, voffB);
        PG8_WAIT_V(6); PG8_BAR;
    } else {
        PG8_STAGE(PG8_SB(0, 0), cB, voffB); PG8_STAGE(PG8_SA(0, 0), cA, voffA); PG8_STAGE(PG8_SB(0, 1), cB + hstep, voffB); PG8_STAGE(PG8_SA(0, 1), cA + hstep, voffA);
        if (wr == 1) PG8_BAR;
        PG8_WAIT_V(4); PG8_BAR;
        PG8_STAGE(PG8_SB(1, 0), cB + kstep, voffB); PG8_STAGE(PG8_SA(1, 0), cA + kstep, voffA); PG8_STAGE(PG8_SB(1, 1), cB + hstep + kstep, voffB);
        PG8_WAIT_V(6); PG8_BAR;
    }
    for (;;) {
        const bool has_next = S.next(ui + 1, nxt);
        const char* nA = has_next ? (const char*)g.A + (size_t)nxt.pm * tstep : cA; const char* nB = has_next ? (const char*)g.Bt + (size_t)nxt.pn * tstep : cB;
        for (int t = 0; t < nt; t += 2) {
            const bool last = (t == nt - 2);
            const char* a1 = cA + (size_t)(t + 1) * kstep;
            const char* a2 = last ? nA : cA + (size_t)(t + 2) * kstep; const char* b2 = last ? nB : cB + (size_t)(t + 2) * kstep;
            const char* a3 = a2 + kstep; const char* b3 = b2 + kstep;
            if (last && has_next) S.a_ready(nxt);
            if constexpr (SP2) {
            PG8_LDB(B0, 0, 0); PG8_LDB(B1, 0, 1); PG8_SCHED; PG8_LDA(At, 0, 0); PG8_STAGE(PG8_SA(1, 1), a1 + hstep, voffA);
            PG8_WAIT_V(8); PG8_WAIT_L(0); PG8_BAR; PG8_MMA(0, 0, At, B0); PG8_MMA(0, 1, At, B1); PG8_BAR; PG8_SCHED;
            PG8_LDA(At, 0, 1); PG8_STAGE(PG8_SB(0, 0), b2, voffB); PG8_STAGE(PG8_SB(0, 1), b2 + hstep, voffB); PG8_STAGE(PG8_SA(0, 0), a2, voffA);
            PG8_WAIT_V(8); PG8_WAIT_L(0); PG8_BAR; PG8_MMA(1, 0, At, B0); PG8_MMA(1, 1, At, B1); PG8_BAR; PG8_SCHED;
            PG8_LDB(B0, 1, 0); PG8_LDB(B1, 1, 1); PG8_SCHED; PG8_LDA(At, 1, 0); PG8_STAGE(PG8_SA(0, 1), a2 + hstep, voffA);
            PG8_WAIT_V(8); PG8_WAIT_L(0); PG8_BAR; PG8_MMA(0, 0, At, B0); PG8_MMA(0, 1, At, B1); PG8_BAR; PG8_SCHED;
            PG8_LDA(At, 1, 1); PG8_STAGE(PG8_SB(1, 0), b3, voffB); PG8_STAGE(PG8_SB(1, 1), b3 + hstep, voffB); PG8_STAGE(PG8_SA(1, 0), a3, voffA);
            PG8_WAIT_V(8); PG8_WAIT_L(0); PG8_BAR; PG8_MMA(1, 0, At, B0); PG8_MMA(1, 1, At, B1); PG8_BAR; PG8_SCHED;
            } else {
            PG8_LDB(B0, 0, 0); PG8_SCHED; PG8_LDA(At, 0, 0); PG8_STAGE(PG8_SA(1, 1), a1 + hstep, voffA);
            PG8_WAIT_L(8); PG8_BAR; PG8_WAIT_L(0); PG8_MMA(0, 0, At, B0); PG8_BAR; PG8_SCHED;
            PG8_LDB(B1, 0, 1); PG8_STAGE(PG8_SB(0, 0), b2, voffB);
            PG8_BAR; PG8_WAIT_L(0); PG8_MMA(0, 1, At, B1); PG8_BAR;
            PG8_LDA(At, 0, 1); PG8_STAGE(PG8_SA(0, 0), a2, voffA);
            PG8_BAR; PG8_WAIT_L(0); PG8_MMA(1, 0, At, B0); PG8_BAR; PG8_SCHED;
            PG8_STAGE(PG8_SB(0, 1), b2 + hstep, voffB);
            PG8_WAIT_V(6); PG8_BAR; PG8_MMA(1, 1, At, B1); PG8_BAR;
            PG8_LDB(B0, 1, 0); PG8_SCHED; PG8_LDA(At, 1, 0); PG8_STAGE(PG8_SA(0, 1), a2 + hstep, voffA);
            PG8_WAIT_L(8); PG8_BAR; PG8_WAIT_L(0); PG8_MMA(0, 0, At, B0); PG8_BAR; PG8_SCHED;
            PG8_LDB(B1, 1, 1); PG8_STAGE(PG8_SB(1, 0), b3, voffB);
            PG8_BAR; PG8_WAIT_L(0); PG8_MMA(0, 1, At, B1); PG8_BAR;
            PG8_LDA(At, 1, 1); PG8_STAGE(PG8_SA(1, 0), a3, voffA);
            PG8_BAR; PG8_WAIT_L(0); PG8_MMA(1, 0, At, B0); PG8_BAR; PG8_SCHED;
            PG8_STAGE(PG8_SB(1, 1), b3 + hstep, voffB);
            PG8_WAIT_V(6); PG8_BAR; PG8_MMA(1, 1, At, B1); PG8_BAR;
            }
            if constexpr (Epi::HEAD_HOOK) { if (E.hook_on() && ((t + 2) & 7) == 0 && !last) { E.rescale(acc, cur, wr, fr, (t + 2) >> 3); PG8_SCHED; } }
        }
        if constexpr (ALIGN_EPI) { if (wr == 0) PG8_BAR; }
        if constexpr (!Epi::AFTER_DRAIN) { E(acc, cur, wr, wc, fr, fq, rowc, rowc_pm); S.done(cur); }
        if (!has_next) break;
#pragma unroll
        for (int a = 0; a < 2; ++a)
#pragma unroll
            for (int b = 0; b < 2; ++b)
#pragma unroll
                for (int m = 0; m < 4; ++m)
#pragma unroll
                    for (int n = 0; n < 2; ++n) acc[a][b][m][n] = (f32x4){0.f, 0.f, 0.f, 0.f};
        cur = nxt; cA = nA; cB = nB; ++ui;
        if constexpr (ALIGN_EPI) { if (wr == 1) PG8_BAR; }
    }
    PG8_WAIT_V(0);
    if constexpr (!ALIGN_EPI) { if (wr == 0) PG8_BAR; }
    PG8_BAR;
    if constexpr (Epi::AFTER_DRAIN) { E.fused(acc, cur, wr, wc, fr, fq, lds, wid, lane); S.done(cur); }
#undef PG8_SA
#undef PG8_SB
#undef PG8_STAGE
#undef PG8_LDA
#undef PG8_LDB
#undef PG8_MMA
#undef PG8_WAIT_V
#undef PG8_WAIT_L
#undef PG8_BAR
#undef PG8_SCHED
}
typedef float f32x2_t __attribute__((ext_vector_type(2))); typedef __bf16 bf16x2_t __attribute__((ext_vector_type(2)));
__device__ __forceinline__ unsigned cvtpk(float lo, float hi) { f32x2_t v = {lo, hi}; bf16x2_t b = __builtin_convertvector(v, bf16x2_t); return __builtin_bit_cast(unsigned, b); }
__device__ __forceinline__ float bflo(unsigned u) { return __uint_as_float(u << 16); }
__device__ __forceinline__ float bfhi(unsigned u) { return __uint_as_float(u & 0xffff0000u); }
__device__ __forceinline__ float row_rstd(const float* rstd, int row) { return rstd[row]; }
__device__ __forceinline__ void row_rstd8(const float* rstd, int row0, float (&rs)[8]) {
#pragma unroll
    for (int q = 0; q < 8; ++q) rs[q] = rstd[row0 + (q >> 2) * HALF + (q & 3) * 16];
}

struct EpiRetProj {
    static constexpr bool PERM = true, AFTER_DRAIN = false, HEAD_HOOK = false;
    bf16_t* act; const float* ssq;
    __device__ __forceinline__ void operator()(const f32x4 (&acc)[2][2][4][2], const Unit& u, int wr, int wc, int fr_, int fq_, float (&rs8)[8], int& rs_pm) const {
        int fr = fr_, fq = fq_; asm volatile("" : "+v"(fr), "+v"(fq));
        const int row0 = u.pm * BM + wr * 64 + fr; const int pn = u.pn;
        if (u.pm != rs_pm) { row_rstd8(ssq, row0, rs8); rs_pm = u.pm; }
        if (pn < 8) {
            const int head = pn & 3; const bool isk = pn >= 4;
            bf16_t* plane = act + (isk ? (size_t)MTOK * 1024 : (size_t)0);
            const float osc = isk ? 0.0625f : 1.0f;
            float invf[8];
#pragma unroll
            for (int q = 0; q < 8; ++q) { const int i = wc * 32 + 8 * fq + q; invf[q] = __builtin_amdgcn_exp2f(-(float)i * (13.287712379549449f / 128.0f)) * 0.15915494309189535f; }
#pragma unroll
            for (int ai = 0; ai < 2; ++ai)
#pragma unroll
                for (int m = 0; m < 4; ++m) {
                    const int row = row0 + ai * HALF + m * 16; const float rstd = rs8[ai * 4 + m]; const float pos = (float)(row & (SEQ - 1));
                    float o1[8], o2[8];
#pragma unroll
                    for (int q = 0; q < 8; ++q) {
                        const float rev = __builtin_amdgcn_fractf(pos * invf[q]);
                        const float sn = __builtin_amdgcn_sinf(rev), cs = __builtin_amdgcn_cosf(rev);
                        const float x1 = acc[ai][0][m][q >> 2][q & 3] * rstd, x2 = acc[ai][1][m][q >> 2][q & 3] * rstd;
                        o1[q] = (x1 * cs - x2 * sn) * osc; o2[q] = (x1 * sn + x2 * cs) * osc;
                    }
                    bf16_t* rp = plane + (size_t)row * 1024 + head * 256 + wc * 32 + 8 * fq;
                    u32x4 w1, w2;
                    w1.x = cvtpk(o1[0], o1[1]); w1.y = cvtpk(o1[2], o1[3]); w1.z = cvtpk(o1[4], o1[5]); w1.w = cvtpk(o1[6], o1[7]);
                    w2.x = cvtpk(o2[0], o2[1]); w2.y = cvtpk(o2[2], o2[3]); w2.z = cvtpk(o2[4], o2[5]); w2.w = cvtpk(o2[6], o2[7]);
                    *(u32x4*)rp = w1; *(u32x4*)(rp + 128) = w2;
                    asm volatile("" ::: "memory");
                }
        } else {
            const bool isg = pn >= 16; const int t = isg ? pn - 16 : pn - 8;
            bf16_t* plane = act + (size_t)MTOK * (isg ? 4096 : 2048);
#pragma unroll
            for (int ai = 0; ai < 2; ++ai)
#pragma unroll
                for (int m = 0; m < 4; ++m) {
                    const int row = row0 + ai * HALF + m * 16; const float rstd = rs8[ai * 4 + m];
                    bf16_t* rp = plane + (size_t)row * 2048 + t * 256 + wc * 32 + 8 * fq;
#pragma unroll
                    for (int bj = 0; bj < 2; ++bj) { f32x4 v0 = acc[ai][bj][m][0] * rstd, v1 = acc[ai][bj][m][1] * rstd;
                        if (isg) {
#pragma unroll
                            for (int e = 0; e < 4; ++e) { v0[e] *= __builtin_amdgcn_rcpf(1.0f + __builtin_amdgcn_exp2f(-1.4426950408889634f * v0[e])); v1[e] *= __builtin_amdgcn_rcpf(1.0f + __builtin_amdgcn_exp2f(-1.4426950408889634f * v1[e])); }
                        }
                        u32x4 w; w.x = cvtpk(v0[0], v0[1]); w.y = cvtpk(v0[2], v0[3]); w.z = cvtpk(v1[0], v1[1]); w.w = cvtpk(v1[2], v1[3]);
                        *(u32x4*)(rp + bj * HALF) = w; }
                    asm volatile("" ::: "memory");
                }
        }
    }
};

struct EpiSbProj {
    static constexpr bool PERM = true, AFTER_DRAIN = false, HEAD_HOOK = false;
    bf16_t* act; const float* ssq; const float* qg; const float* kg;
    __device__ __forceinline__ void operator()(const f32x4 (&acc)[2][2][4][2], const Unit& u, int wr, int wc, int fr_, int fq_, float (&rs8)[8], int& rs_pm) const {
        int fr = fr_, fq = fq_; asm volatile("" : "+v"(fr), "+v"(fq));
        const int row0 = u.pm * BM + wr * 64 + fr; const int which = u.pn >> 2, t = u.pn & 3;
        if (u.pm != rs_pm) { row_rstd8(ssq, row0, rs8); rs_pm = u.pm; }
        bf16_t* plane = act + (size_t)which * MTOK * 1024;
        const int colbase = t * 256 + 64 * wc + 8 * fq;
        float g[2][8];
        if (which < 2) { const float* gp = which == 0 ? qg : kg; const float gs = which == 0 ? C2SB : 1.0f;
#pragma unroll
            for (int bj = 0; bj < 2; ++bj)
#pragma unroll
                for (int q = 0; q < 8; ++q) g[bj][q] = gp[32 * bj + 8 * fq + q] * gs;
        }
#pragma unroll
        for (int ai = 0; ai < 2; ++ai)
#pragma unroll
            for (int m = 0; m < 4; ++m) {
                const int row = row0 + ai * HALF + m * 16; const float rstd = rs8[ai * 4 + m];
                float v[2][8];
#pragma unroll
                for (int bj = 0; bj < 2; ++bj)
#pragma unroll
                    for (int q = 0; q < 8; ++q) v[bj][q] = acc[ai][bj][m][q >> 2][q & 3] * rstd;
                if (which < 2) {
                    float ss = 0.f;
#pragma unroll
                    for (int bj = 0; bj < 2; ++bj)
#pragma unroll
                        for (int q = 0; q < 8; ++q) ss += v[bj][q] * v[bj][q];
                    ss += __shfl_xor(ss, 16); ss += __shfl_xor(ss, 32);
                    const float rn = rsqrtf(ss * (1.0f / 64.0f) + EPSN);
#pragma unroll
                    for (int bj = 0; bj < 2; ++bj)
#pragma unroll
                        for (int q = 0; q < 8; ++q) v[bj][q] = v[bj][q] * rn * g[bj][q];
                }
                bf16_t* rp = plane + (size_t)row * 1024 + colbase;
#pragma unroll
                for (int bj = 0; bj < 2; ++bj) { u32x4 w; w.x = cvtpk(v[bj][0], v[bj][1]); w.y = cvtpk(v[bj][2], v[bj][3]); w.z = cvtpk(v[bj][4], v[bj][5]); w.w = cvtpk(v[bj][6], v[bj][7]);
                    *(u32x4*)(rp + 32 * bj) = w; }
                asm volatile("" ::: "memory");
            }
    }
};

struct EpiFfnIn {
    static constexpr bool PERM = true, AFTER_DRAIN = false, HEAD_HOOK = false;
    bf16_t* hbuf; const float* ssq;
    __device__ __forceinline__ void operator()(const f32x4 (&acc)[2][2][4][2], const Unit& u, int wr, int wc, int fr_, int fq_, float (&rs8)[8], int& rs_pm) const {
        int fr = fr_, fq = fq_; asm volatile("" : "+v"(fr), "+v"(fq));
        const int row0 = u.pm * BM + wr * 64 + fr;
        if (u.pm != rs_pm) { row_rstd8(ssq, row0, rs8); rs_pm = u.pm; }
#pragma unroll
        for (int ai = 0; ai < 2; ++ai)
#pragma unroll
            for (int m = 0; m < 4; ++m) {
                const int row = row0 + ai * HALF + m * 16; const float rstd = rs8[ai * 4 + m];
                float hv[8];
#pragma unroll
                for (int q = 0; q < 8; ++q) { const float gt = acc[ai][0][m][q >> 2][q & 3] * rstd, up = acc[ai][1][m][q >> 2][q & 3] * rstd;
                    hv[q] = gt * __builtin_amdgcn_rcpf(1.0f + __builtin_amdgcn_exp2f(-1.4426950408889634f * gt)) * up; }
                u32x4 w; w.x = cvtpk(hv[0], hv[1]); w.y = cvtpk(hv[2], hv[3]); w.z = cvtpk(hv[4], hv[5]); w.w = cvtpk(hv[6], hv[7]);
                *(u32x4*)(hbuf + (size_t)row * FFH + u.pn * 128 + wc * 32 + 8 * fq) = w;
                asm volatile("" ::: "memory");
            }
    }
};

template <bool HOOK> struct EpiResid {
    static constexpr bool PERM = true, AFTER_DRAIN = false, HEAD_HOOK = HOOK;
    float* out;
    bf16_t* xb; float* ssq;
    const float* hss;
    __device__ __forceinline__ bool hook_on() const { return hss != nullptr; }
    __device__ __forceinline__ float head_rstd(int row, int h) const {
        const f32x4 sp = *(const f32x4*)(hss + (size_t)row * 16 + h * 4);
        return rsqrtf(((sp[0] + sp[1]) + (sp[2] + sp[3])) * (1.0f / 512.0f) + EPSN);
    }
    __device__ __forceinline__ void rescale(f32x4 (&acc)[2][2][4][2], const Unit& u, int wr, int fr_, int hnext) const {
        int fr = fr_; asm volatile("" : "+v"(fr));
        const float* hp = hss + (size_t)(u.pm * BM + wr * 64 + fr) * 16 + (hnext - 1) * 4;
#pragma unroll
        for (int half = 0; half < 2; ++half) {
            f32x4 s0[4], s1[4];
#pragma unroll
            for (int m = 0; m < 4; ++m) { const float* p = hp + (size_t)(half * HALF + m * 16) * 16; s0[m] = *(const f32x4*)p; s1[m] = *(const f32x4*)(p + 4); }
#pragma unroll
            for (int m = 0; m < 4; ++m) {
                const float a = ((s0[m][0] + s0[m][1]) + (s0[m][2] + s0[m][3])) * (1.0f / 512.0f) + EPSN, b = ((s1[m][0] + s1[m][1]) + (s1[m][2] + s1[m][3])) * (1.0f / 512.0f) + EPSN;
                const float r = sqrtf(b * __builtin_amdgcn_rcpf(a));
#pragma unroll
                for (int bj = 0; bj < 2; ++bj) { acc[half][bj][m][0] = acc[half][bj][m][0] * r; acc[half][bj][m][1] = acc[half][bj][m][1] * r; }
            }
        }
    }
    __device__ __forceinline__ void operator()(const f32x4 (&acc)[2][2][4][2], const Unit& u, int wr, int wc, int fr_, int fq_, float (&rs8)[8], int& rs_pm) const {
        int fr = fr_, fq = fq_; asm volatile("" : "+v"(fr), "+v"(fq));
        const int row0 = u.pm * BM + wr * 64 + fr;
        const size_t coff = (size_t)u.pn * BM + wc * 32 + 8 * fq;
#pragma unroll
        for (int half = 0; half < 2; ++half) {
            u32x4 nb[4][2]; float fsv[4];
#pragma unroll
            for (int m = 0; m < 4; ++m) { const int row = row0 + half * HALF + m * 16; const bf16_t* bp = xb + (size_t)row * DM + coff;
                nb[m][0] = *(const u32x4*)bp; nb[m][1] = *(const u32x4*)(bp + HALF); fsv[m] = (HOOK && hss) ? head_rstd(row, 3) : 1.0f; }
#pragma unroll
            for (int m = 0; m < 4; ++m) {
                const int row = row0 + half * HALF + m * 16; float s = 0.f; const float fs = fsv[m];
#pragma unroll
                for (int bj = 0; bj < 2; ++bj) {
                    const size_t off = (size_t)row * DM + coff + bj * HALF;
                    const u32x4 cb = nb[m][bj];
                    const f32x4 b0 = (f32x4){bflo(cb.x), bfhi(cb.x), bflo(cb.y), bfhi(cb.y)}, b1 = (f32x4){bflo(cb.z), bfhi(cb.z), bflo(cb.w), bfhi(cb.w)};
                    const f32x4 v0 = b0 + acc[half][bj][m][0] * fs, v1 = b1 + acc[half][bj][m][1] * fs;
                    if (out) { *(f32x4*)(out + off) = v0; *(f32x4*)(out + off + 4) = v1; }
                    else {
                        u32x4 w; w.x = cvtpk(v0[0], v0[1]); w.y = cvtpk(v0[2], v0[3]); w.z = cvtpk(v1[0], v1[1]); w.w = cvtpk(v1[2], v1[3]);
                        *(u32x4*)(xb + off) = w;
                        s += (v0[0] * v0[0] + v0[1] * v0[1]) + (v0[2] * v0[2] + v0[3] * v0[3]) + (v1[0] * v1[0] + v1[1] * v1[1]) + (v1[2] * v1[2] + v1[3] * v1[3]);
                    }
                }
                if (!out) { s += __shfl_xor(s, 16); s += __shfl_xor(s, 32); if (fq == 0) ssq[(size_t)row * 16 + u.pn * 4 + wc] = s; }
            }
            asm volatile("" ::: "memory");
        }
    }
};
}

#define LAS __attribute__((address_space(3)))
typedef unsigned short bf16_t;
typedef short bf16x8 __attribute__((ext_vector_type(8)));
typedef short s16x4 __attribute__((ext_vector_type(4)));
typedef float f32x4 __attribute__((ext_vector_type(4)));
typedef float f32x16 __attribute__((ext_vector_type(16)));
typedef unsigned u32x4 __attribute__((ext_vector_type(4)));
typedef unsigned u32x2 __attribute__((ext_vector_type(2)));
using pg8::cvtpk; using pg8::bflo; using pg8::bfhi;
#define MFMA16(a, b, c) __builtin_amdgcn_mfma_f32_16x16x32_bf16((a), (b), (c), 0, 0, 0)
#define MFMA32(a, b, c) __builtin_amdgcn_mfma_f32_32x32x16_bf16((a), (b), (c), 0, 0, 0)
__device__ __forceinline__ s16x4 trrd(LAS unsigned char* p) { return __builtin_bit_cast(s16x4, __builtin_amdgcn_ds_read_tr16_b64_v4i16((LAS s16x4*)p)); }
__device__ __forceinline__ bf16x8 cat8(s16x4 lo, s16x4 hi) { return __builtin_shufflevector(lo, hi, 0, 1, 2, 3, 4, 5, 6, 7); }

#define XB_TMO      128
#define XB_XCNT(j)  (256  + 64 * (j))
#define XB_XSUB(j)  (1280 + 64 * (j))
#define XB_XGEN(j)  (2304 + 64 * (j))
#define XB_TOP      3328
#define XB_TOPGEN   3392
#define XCD_BAR_WORDS 3456
#define XB_SPIN_CAP (1u << 18)

__device__ __forceinline__ unsigned xb_ld(unsigned* p)              { return __hip_atomic_load(p, __ATOMIC_RELAXED, __HIP_MEMORY_SCOPE_AGENT); }
__device__ __forceinline__ unsigned xb_add(unsigned* p, unsigned v) { return __hip_atomic_fetch_add(p, v, __ATOMIC_RELAXED, __HIP_MEMORY_SCOPE_AGENT); }
__device__ __forceinline__ unsigned xb_xcc_id() { return (unsigned)__builtin_amdgcn_s_getreg((3 << 11) | 20) & 0xFu; }
#define XB_SPIN(cond, bar) do { unsigned _sp = 0; while (cond) { __builtin_amdgcn_s_sleep(1); \
    if ((++_sp & 255u) == 0u) { if (xb_ld(&(bar)[XB_TMO])) break; if (_sp > XB_SPIN_CAP) { atomicAdd(&(bar)[XB_TMO], 1u); break; } } } } while (0)

struct XcdBarrier {
    unsigned* bar; unsigned x;
    volatile LAS unsigned* st;
};

__device__ __forceinline__ XcdBarrier xcd_barrier_post(unsigned* bar, volatile LAS unsigned* st) {
    XcdBarrier b; b.bar = bar; b.x = xb_xcc_id(); b.st = st;
    if (threadIdx.x == 0) (void)xb_add(&bar[XB_XCNT(b.x)], 1u);
    return b;
}
__device__ __forceinline__ void xcd_barrier_complete(unsigned* bar, unsigned x, unsigned& nloc, unsigned& nx) {
    const unsigned G = gridDim.x * gridDim.y * gridDim.z;
    unsigned sum, cnt, mine, sp = 0u;
    for (;;) {
        sum = 0u; cnt = 0u; mine = 0u;
#pragma unroll
        for (unsigned j = 0; j < 16; ++j) { const unsigned c = xb_ld(&bar[XB_XCNT(j)]); sum += c; cnt += (c > 0u) ? 1u : 0u; mine = (j == x) ? c : mine; }
        if (sum == G) break;
        __builtin_amdgcn_s_sleep(1);
        if ((++sp & 255u) == 0u) { if (xb_ld(&bar[XB_TMO])) break; if (sp > XB_SPIN_CAP) { atomicAdd(&bar[XB_TMO], 1u); break; } }
    }
    nloc = mine > 0u ? mine : 1u; nx = cnt > 0u ? cnt : 1u;
}

__device__ __forceinline__ void xcd_barrier(const XcdBarrier& b) {
    asm volatile("s_waitcnt vmcnt(0)" ::: "memory");
    __syncthreads();
    if (threadIdx.x == 0) {
        unsigned* bar = b.bar;
        __builtin_amdgcn_s_waitcnt(0);
        unsigned nloc = b.st[0], nx = b.st[1];
        if (nloc == 0u) { xcd_barrier_complete(bar, b.x, nloc, nx); b.st[0] = nloc; b.st[1] = nx; }
        const unsigned old = xb_add(&bar[XB_XSUB(b.x)], 1u);
        const unsigned gen = old / nloc;
        if (old + 1u == (gen + 1u) * nloc) {
            __builtin_amdgcn_fence(__ATOMIC_RELEASE, "agent");
            asm volatile("s_waitcnt vmcnt(0)" ::: "memory");
            const unsigned og = xb_add(&bar[XB_TOP], 1u);
            const unsigned tg = og / nx;
            if (og + 1u == (tg + 1u) * nx) xb_add(&bar[XB_TOPGEN], 1u);
            else XB_SPIN(xb_ld(&bar[XB_TOPGEN]) == tg, bar);
            __builtin_amdgcn_fence(__ATOMIC_ACQUIRE, "agent");
            xb_add(&bar[XB_XGEN(b.x)], 1u);
            asm volatile("s_waitcnt vmcnt(0)" ::: "memory");
        } else {
            XB_SPIN(xb_ld(&bar[XB_XGEN(b.x)]) == gen, bar);
            __builtin_amdgcn_fence(__ATOMIC_ACQUIRE, "agent");
            asm volatile("s_waitcnt vmcnt(0)" ::: "memory");
        }
    }
    __syncthreads();
}

constexpr size_t MiB = 1u << 20;
constexpr size_t WS_SSQ = 0;
constexpr size_t WS_SSQP = 2 * MiB;
constexpr size_t WS_W = 4 * MiB;
constexpr size_t W_MI = 0, W_MO = 12 * MiB, W_FI = 16 * MiB, W_FO = 27 * MiB;
constexpr size_t WS_XB = 38 * MiB;
constexpr size_t WS_ACT = 102 * MiB;
constexpr size_t WS_BAR = 486 * MiB;
constexpr size_t WS_RSTD = 486 * MiB + 65536;
constexpr size_t WS_END = 486 * MiB + 65536 + 131072;
constexpr int LDS_BYTES = 147456;

__device__ __forceinline__ int dest_row(int mode, int c) {
    if (mode == 1) { const int pn = c >> 8, l = c & 255; return (pn << 8) + ((l >> 5) & 1) * 128 + (l >> 6) * 32 + (l & 31); }
    if (mode == 2) { const int half = c >= FFH ? 1 : 0; const int hc = c - half * FFH; return ((hc >> 7) << 8) + half * 128 + (hc & 127); }
    return c;
}
__device__ __forceinline__ void transpose_item(const float* W, int K, int N, const float* gain, bf16_t* WT, int mode, LAS float* scr, int item, int lane) {
    const int nblk = N / 64, kb = item / nblk, nb = item % nblk, k0 = 64 * kb, n0 = 64 * nb;
    const int lr = lane >> 4, c4 = (lane & 15) * 4;
#pragma unroll 8
    for (int i = 0; i < 16; ++i) { const int r = 4 * i + lr; const float gv = gain ? gain[k0 + r] : 1.0f;
        const f32x4 v = *(const f32x4*)(W + (size_t)(k0 + r) * N + n0 + c4);
        LAS float* d = scr + r * 65 + c4; d[0] = v[0] * gv; d[1] = v[1] * gv; d[2] = v[2] * gv; d[3] = v[3] * gv; }
    asm volatile("s_waitcnt lgkmcnt(0)" ::: "memory");
    const int c = lane & 7;
#pragma unroll
    for (int j = 0; j < 8; ++j) { const int n = (lane >> 3) + 8 * j; const LAS float* sp = scr + (8 * c) * 65 + n;
        u32x4 o; o.x = cvtpk(sp[0 * 65], sp[1 * 65]); o.y = cvtpk(sp[2 * 65], sp[3 * 65]); o.z = cvtpk(sp[4 * 65], sp[5 * 65]); o.w = cvtpk(sp[6 * 65], sp[7 * 65]);
        *(u32x4*)(WT + (size_t)dest_row(mode, n0 + n) * K + k0 + 8 * c) = o; }
    asm volatile("s_waitcnt lgkmcnt(0)" ::: "memory");
}
struct Args { const float* in[12]; float* out; unsigned char* ws; };
__device__ __forceinline__ void conv_weights(const Args& a, int i, LAS unsigned char* L) {
    const int tid = opaque_tid(), lane = tid & 63, wave = tid >> 6;
    LAS float* scr = (LAS float*)(L + wave * 16640);
    const int gw = blockIdx.x * 8 + wave, NGW = gridDim.x * 8;
    const int j = i >> 1; const bool ret = !(i & 1);
    bf16_t* wbase = (bf16_t*)(a.ws + WS_W);
    const int I_MI = ret ? 16 * 96 : 16 * 48, I_MO = ret ? 32 * 16 : 16 * 16, I_FI = 16 * 88, I_FO = 44 * 16;
    const int total = I_MI + I_MO + I_FI + I_FO;
    for (int it = gw; it < total; it += NGW) {
        int r = it;
        if (r < I_MI) { if (ret) transpose_item(a.in[3] + (size_t)j * 1024 * 6144, 1024, 6144, a.in[1] + i * 1024, wbase + W_MI / 2, 0, scr, r, lane);
                        else     transpose_item(a.in[6] + (size_t)j * 1024 * 3072, 1024, 3072, a.in[1] + i * 1024, wbase + W_MI / 2, 1, scr, r, lane);
                        continue; }
        r -= I_MI;
        if (r < I_MO) { if (ret) transpose_item(a.in[5] + (size_t)j * 2048 * 1024, 2048, 1024, a.in[4] + (size_t)j * 2048, wbase + W_MO / 2, 0, scr, r, lane);
                        else     transpose_item(a.in[9] + (size_t)j * 1024 * 1024, 1024, 1024, nullptr, wbase + W_MO / 2, 0, scr, r, lane);
                        continue; }
        r -= I_MO;
        if (r < I_FI) { transpose_item(a.in[10] + (size_t)i * 1024 * 5632, 1024, 5632, a.in[2] + i * 1024, wbase + W_FI / 2, 2, scr, r, lane); continue; }
        r -= I_FI;
        transpose_item(a.in[11] + (size_t)i * FFH * 1024, FFH, 1024, nullptr, wbase + W_FO / 2, 0, scr, r, lane);
    }
}
__device__ __forceinline__ void x_pass(const float* x, bf16_t* xb, float* rstd) {
    const int tid = opaque_tid(), lane = tid & 63, wave = tid >> 6;
    const int gw = blockIdx.x * 8 + wave, NGW = gridDim.x * 8;
#pragma unroll 2
    for (int m = gw; m < MTOK; m += NGW) {
        const f32x4* xr = (const f32x4*)(x + (size_t)m * DM) + lane;
        f32x4 v[4]; float s = 0.f;
#pragma unroll
        for (int jj = 0; jj < 4; ++jj) { v[jj] = xr[64 * jj]; s += (v[jj][0] * v[jj][0] + v[jj][1] * v[jj][1]) + (v[jj][2] * v[jj][2] + v[jj][3] * v[jj][3]); }
#pragma unroll
        for (int o = 1; o < 64; o <<= 1) s += __shfl_xor(s, o);
        u32x2* o8 = (u32x2*)(xb + (size_t)m * DM) + lane;
#pragma unroll
        for (int jj = 0; jj < 4; ++jj) { u32x2 w; w.x = cvtpk(v[jj][0], v[jj][1]); w.y = cvtpk(v[jj][2], v[jj][3]); o8[64 * jj] = w; }
        if (lane == 0) rstd[m] = rsqrtf(s * (1.0f / 1024.0f) + EPSN);
    }
}

__device__ __forceinline__ void rstd_pass(const float* ssq, float* rstd) {
    const int tid = opaque_tid();
    for (int row = blockIdx.x * 512 + tid; row < MTOK; row += gridDim.x * 512) {
        const f32x4* p = (const f32x4*)(ssq + (size_t)row * 16);
        const f32x4 a = p[0], b = p[1], c = p[2], d = p[3];
        const float s = ((a[0] + a[1]) + (a[2] + a[3])) + ((b[0] + b[1]) + (b[2] + b[3])) + ((c[0] + c[1]) + (c[2] + c[3])) + ((d[0] + d[1]) + (d[2] + d[3]));
        rstd[row] = rsqrtf(s * (1.0f / 1024.0f) + EPSN);
    }
}
constexpr int R_Q = 0, R_K = 34816, R_V = 71680, R_P = 92160, R_O = 101376;
__device__ __forceinline__ float bf2f(short x) { return __uint_as_float(((unsigned)(unsigned short)x) << 16); }
__device__ __forceinline__ void ret_phase(LAS unsigned char* L, const bf16_t* Qp, const bf16_t* Kp, bf16_t* Vp, const bf16_t* Gp, float* ssqp) {
    const int tid0 = opaque_tid(), w = __builtin_amdgcn_readfirstlane(tid0 >> 6);
#define RET_LANES() int tid = tid0; asm volatile("" : "+v"(tid)); const int lane = tid & 63, l15 = lane & 15, quad = lane >> 4, tq = l15 >> 2, tp = l15 & 3; (void)tq; (void)tp; (void)quad; (void)l15
    for (int uidx = blockIdx.x; uidx < 256; uidx += gridDim.x) {
        const int vcu = (uidx & 7) * 32 + (uidx >> 3);
        const int bh = vcu >> 2, vs = vcu & 3, b = bh >> 2, h = bh & 3;
        const float lg = __builtin_amdgcn_logf(1.0f - __builtin_amdgcn_exp2f(-5.0f - (float)h));
        const float ginv = __builtin_amdgcn_exp2f(-lg);
        f32x4 S[16];
#pragma unroll
        for (int k = 0; k < 16; ++k) S[k] = (f32x4){0.f, 0.f, 0.f, 0.f};
        const float cdec = __builtin_amdgcn_exp2f(lg * 64.0f);
        const size_t rowb = (size_t)b * SEQ;
        const int tid = tid0;
        const bf16_t* qsrc = Qp + (rowb + (tid >> 5)) * 1024 + h * 256 + (tid & 31) * 8;
        const bf16_t* ksrc = Kp + (rowb + (tid >> 5)) * 1024 + h * 256 + (tid & 31) * 8;
        bf16_t* vsrc = Vp + (rowb + (tid >> 4)) * 2048 + h * 512 + vs * 128 + (tid & 15) * 8;
        const bf16_t* gsrc = Gp + (rowb + (tid >> 4)) * 2048 + h * 512 + vs * 128 + (tid & 15) * 8;
        u32x4 rq[4], rk[4], rv[2], rg[2];
#pragma unroll
        for (int i = 0; i < 4; ++i) { rq[i] = *(const u32x4*)(qsrc + (size_t)i * 16 * 1024); rk[i] = *(const u32x4*)(ksrc + (size_t)i * 16 * 1024); }
#pragma unroll
        for (int i = 0; i < 2; ++i) rv[i] = *(const u32x4*)(vsrc + (size_t)i * 32 * 2048);
#pragma unroll 1
        for (int n = 0; n < 32; ++n) {
            const size_t row0 = rowb + n * 64;
            { RET_LANES();
#pragma unroll
            for (int i = 0; i < 4; ++i) { *(LAS u32x4*)(L + R_Q + ((tid >> 5) + 16 * i) * 544 + (tid & 31) * 16) = rq[i]; *(LAS u32x4*)(L + R_K + ((tid >> 5) + 16 * i) * 576 + (tid & 31) * 16) = rk[i]; }
#pragma unroll
            for (int i = 0; i < 2; ++i) *(LAS u32x4*)(L + R_V + ((tid >> 4) + 32 * i) * 320 + (tid & 15) * 16) = rv[i];
            }
            __syncthreads();
            if (n < 31) {
                const size_t adv = (size_t)(n + 1) * 64;
#pragma unroll
                for (int i = 0; i < 4; ++i) { rq[i] = *(const u32x4*)(qsrc + (adv + 16 * i) * 1024); rk[i] = *(const u32x4*)(ksrc + (adv + 16 * i) * 1024); }
#pragma unroll
                for (int i = 0; i < 2; ++i) rv[i] = *(const u32x4*)(vsrc + (adv + 32 * i) * 2048);
            }
            __builtin_amdgcn_sched_barrier(0);
            {
                RET_LANES();
                const int cb = w >> 1, eb0 = (w & 1) * 2;
                f32x4 sc0 = (f32x4){0.f, 0.f, 0.f, 0.f}, sc1 = sc0;
#pragma unroll
                for (int ks = 0; ks < 8; ++ks) {
                    const bf16x8 a = *(const LAS bf16x8*)(L + R_Q + (16 * cb + l15) * 544 + (32 * ks + 8 * quad) * 2);
                    const bf16x8 b0 = *(const LAS bf16x8*)(L + R_K + (16 * eb0 + l15) * 576 + (32 * ks + 8 * quad) * 2);
                    const bf16x8 b1 = *(const LAS bf16x8*)(L + R_K + (16 * (eb0 + 1) + l15) * 576 + (32 * ks + 8 * quad) * 2);
                    sc0 = MFMA16(b0, a, sc0); sc1 = MFMA16(b1, a, sc1);
                }
                const int c = 16 * cb + l15;
                float p0[4], p1[4];
#pragma unroll
                for (int i = 0; i < 4; ++i) { const int e0 = 16 * eb0 + 4 * quad + i, e1 = e0 + 16;
                    const float d0 = (float)(c > e0 ? c - e0 : e0 - c), d1 = (float)(c > e1 ? c - e1 : e1 - c);
                    p0[i] = sc0[i] * __builtin_amdgcn_exp2f(lg * d0); p1[i] = sc1[i] * __builtin_amdgcn_exp2f(lg * d1); }
                u32x2 w0, w1; w0.x = cvtpk(p0[0], p0[1]); w0.y = cvtpk(p0[2], p0[3]); w1.x = cvtpk(p1[0], p1[1]); w1.y = cvtpk(p1[2], p1[3]);
                *(LAS u32x2*)(L + R_P + c * 144 + (16 * eb0 + 4 * quad) * 2) = w0;
                *(LAS u32x2*)(L + R_P + c * 144 + (16 * (eb0 + 1) + 4 * quad) * 2) = w1;
            }
            __syncthreads();
            __builtin_amdgcn_sched_barrier(0);
#pragma unroll
            for (int i = 0; i < 2; ++i) rg[i] = *(const u32x4*)(gsrc + ((size_t)n * 64 + 32 * i) * 2048);
            f32x4 oa[4]; bf16x8 bvs[2];
            { RET_LANES();
#pragma unroll
            for (int cb = 0; cb < 4; ++cb) oa[cb] = (f32x4){0.f, 0.f, 0.f, 0.f};
            {
                const LAS unsigned char* qb = L + R_Q + l15 * 544 + (8 * quad) * 2;
                bf16x8 qa[2][4];
#pragma unroll
                for (int cb = 0; cb < 4; ++cb) qa[0][cb] = *(const LAS bf16x8*)(qb + cb * 16 * 544);
#pragma unroll
                for (int ks = 0; ks < 8; ++ks) {
                    const int cu = ks & 1, nx = cu ^ 1;
                    if (ks < 7) {
#pragma unroll
                        for (int cb = 0; cb < 4; ++cb) qa[nx][cb] = *(const LAS bf16x8*)(qb + cb * 16 * 544 + (ks + 1) * 64);
                    }
                    __builtin_amdgcn_sched_barrier(0);
                    u32x4 bp; bp.x = cvtpk(S[2 * ks][0], S[2 * ks][1]); bp.y = cvtpk(S[2 * ks][2], S[2 * ks][3]); bp.z = cvtpk(S[2 * ks + 1][0], S[2 * ks + 1][1]); bp.w = cvtpk(S[2 * ks + 1][2], S[2 * ks + 1][3]);
                    const bf16x8 bst = __builtin_bit_cast(bf16x8, bp);
#pragma unroll
                    for (int cb = 0; cb < 4; ++cb) oa[cb] = MFMA16(bst, qa[cu][cb], oa[cb]);
                    __builtin_amdgcn_sched_barrier(0);
                }
            }
#pragma unroll
            for (int cb = 0; cb < 4; ++cb) oa[cb] = oa[cb] * __builtin_amdgcn_exp2f(lg * (float)(16 * cb + l15 + 1));
            }
            __builtin_amdgcn_sched_barrier(0);
            { RET_LANES();
#pragma unroll
            for (int ks = 0; ks < 2; ++ks) {
                const s16x4 vlo = trrd(L + R_V + (32 * ks + 8 * quad + tq) * 320 + (16 * w + 4 * tp) * 2);
                const s16x4 vhi = trrd(L + R_V + (32 * ks + 8 * quad + 4 + tq) * 320 + (16 * w + 4 * tp) * 2);
                const bf16x8 bv = cat8(vlo, vhi);
                bf16x8 pa[4];
#pragma unroll
                for (int cb = 0; cb < 4; ++cb) pa[cb] = *(const LAS bf16x8*)(L + R_P + (16 * cb + l15) * 144 + (32 * ks + 8 * quad) * 2);
#pragma unroll
                for (int cb = 0; cb < 4; ++cb) oa[cb] = MFMA16(bv, pa[cb], oa[cb]);
                float dj = __builtin_amdgcn_exp2f(lg * (float)(63 - 32 * ks - 8 * quad));
                float f[8] = {bf2f(vlo[0]), bf2f(vlo[1]), bf2f(vlo[2]), bf2f(vlo[3]), bf2f(vhi[0]), bf2f(vhi[1]), bf2f(vhi[2]), bf2f(vhi[3])};
#pragma unroll
                for (int q = 0; q < 8; ++q) { f[q] *= dj; dj *= ginv; }
                u32x4 sv; sv.x = cvtpk(f[0], f[1]); sv.y = cvtpk(f[2], f[3]); sv.z = cvtpk(f[4], f[5]); sv.w = cvtpk(f[6], f[7]);
                bvs[ks] = __builtin_bit_cast(bf16x8, sv);
            }
#pragma unroll
            for (int cb = 0; cb < 4; ++cb) { u32x2 ow; ow.x = cvtpk(oa[cb][0], oa[cb][1]); ow.y = cvtpk(oa[cb][2], oa[cb][3]);
                *(LAS u32x2*)(L + R_O + (16 * cb + l15) * 272 + (16 * w + 4 * quad) * 2) = ow; }
            }
            __builtin_amdgcn_sched_barrier(0);
            __builtin_amdgcn_sched_barrier(0);
            { RET_LANES();
#pragma unroll
            for (int k = 0; k < 16; ++k) S[k] = S[k] * cdec;
            {
                const LAS unsigned char* kb = L + R_K + (8 * quad + tq) * 576 + (8 * tp) * 2;
                s16x4 klo[2][4], khi[2][4];
#pragma unroll
                for (int kk = 0; kk < 4; ++kk) { klo[0][kk] = trrd((LAS unsigned char*)kb + (kk >> 1) * 64 + (kk & 1) * 8); khi[0][kk] = trrd((LAS unsigned char*)kb + 4 * 576 + (kk >> 1) * 64 + (kk & 1) * 8); }
#pragma unroll
                for (int g = 0; g < 8; ++g) {
                    const int cu = g & 1, nx = cu ^ 1;
                    if (g < 7) { const int ks1 = (g + 1) >> 2, k41 = (g + 1) & 3;
#pragma unroll
                        for (int kk = 0; kk < 4; ++kk) { klo[nx][kk] = trrd((LAS unsigned char*)kb + ks1 * 32 * 576 + ((4 * k41 + kk) >> 1) * 64 + (kk & 1) * 8); khi[nx][kk] = trrd((LAS unsigned char*)kb + ks1 * 32 * 576 + 4 * 576 + ((4 * k41 + kk) >> 1) * 64 + (kk & 1) * 8); }
                    }
                    __builtin_amdgcn_sched_barrier(0);
#pragma unroll
                    for (int kk = 0; kk < 4; ++kk) S[4 * (g & 3) + kk] = MFMA16(cat8(klo[cu][kk], khi[cu][kk]), bvs[g >> 2], S[4 * (g & 3) + kk]);
                    __builtin_amdgcn_sched_barrier(0);
                }
            }
            }
            __syncthreads();
            { RET_LANES();
#pragma unroll
            for (int i = 0; i < 2; ++i) {
                const int row = (tid >> 4) + 32 * i;
                const u32x4 o = *(const LAS u32x4*)(L + R_O + row * 272 + (tid & 15) * 16);
                const u32x4 g = rg[i];
                const float ov[8] = {bflo(o.x), bfhi(o.x), bflo(o.y), bfhi(o.y), bflo(o.z), bfhi(o.z), bflo(o.w), bfhi(o.w)};
                const float gv[8] = {bflo(g.x), bfhi(g.x), bflo(g.y), bfhi(g.y), bflo(g.z), bfhi(g.z), bflo(g.w), bfhi(g.w)};
                float ss = 0.f; float y[8];
#pragma unroll
                for (int q = 0; q < 8; ++q) { ss += ov[q] * ov[q]; y[q] = ov[q] * gv[q]; }
                u32x4 yv; yv.x = cvtpk(y[0], y[1]); yv.y = cvtpk(y[2], y[3]); yv.z = cvtpk(y[4], y[5]); yv.w = cvtpk(y[6], y[7]);
                *(u32x4*)(vsrc + ((size_t)n * 64 + 32 * i) * 2048) = yv;
                ss += __shfl_xor(ss, 1); ss += __shfl_xor(ss, 2); ss += __shfl_xor(ss, 4); ss += __shfl_xor(ss, 8);
                if ((tid & 15) == 0) ssqp[(row0 + row) * 16 + h * 4 + vs] = ss;
            }
            }
        }
        __syncthreads();
    }
}
#undef RET_LANES
constexpr int SB_KP = 144, SB_VP = 192, SB_KS = 64 * SB_KP, SB_VS = 64 * SB_VP, SB_VOFF = 6 * SB_KS, SB_FLAG = SB_VOFF + 6 * SB_VS;
constexpr float SB_STOP = 1.0995116e12f;
__device__ __forceinline__ void sb_tile(LAS unsigned char* Kb, LAS unsigned char* Vb, const bf16x8 (&qf)[4], f32x16& o0, f32x16& o1, float& carry,
                                        int kt, int q0, int qabs, int pir, int hf, int g1, int tq, int tp) {
    f32x16 s0, s1;
#pragma unroll
    for (int i = 0; i < 16; ++i) { s0[i] = 0.f; s1[i] = 0.f; }
#pragma unroll
    for (int ks = 0; ks < 4; ++ks) {
        const bf16x8 a0 = *(const LAS bf16x8*)(Kb + pir * SB_KP + (16 * ks + 8 * hf) * 2);
        const bf16x8 a1 = *(const LAS bf16x8*)(Kb + (pir + 16) * SB_KP + (16 * ks + 8 * hf) * 2);
        s0 = MFMA32(a0, qf[ks], s0); s1 = MFMA32(a1, qf[ks], s1);
    }
    const int kbase = 64 * kt + 32 * hf;
    if (64 * kt + 63 >= q0) {
#pragma unroll
        for (int i = 0; i < 16; ++i) { if (!(kbase + i < qabs)) s0[i] = -1e30f; if (!(kbase + 16 + i < qabs)) s1[i] = -1e30f; }
    }
    float dl = 1.0f;
#pragma unroll
    for (int i = 15; i >= 0; --i) { const float e = __builtin_amdgcn_exp2f(s1[i]); dl *= (1.0f + e); s1[i] = e * __builtin_amdgcn_rcpf(dl); }
#pragma unroll
    for (int i = 15; i >= 0; --i) { const float e = __builtin_amdgcn_exp2f(s0[i]); dl *= (1.0f + e); s0[i] = e * __builtin_amdgcn_rcpf(dl); }
    const float pdl = __shfl_xor(dl, 32);
    const float fac = __builtin_amdgcn_rcpf(carry * (hf == 0 ? pdl : 1.0f));
    carry = carry * dl * pdl;
#pragma unroll
    for (int mb = 0; mb < 2; ++mb)
#pragma unroll
        for (int s = 0; s < 2; ++s) {
            u32x4 pw;
            if (mb == 0) { pw.x = cvtpk(s0[8 * s + 0] * fac, s0[8 * s + 1] * fac); pw.y = cvtpk(s0[8 * s + 2] * fac, s0[8 * s + 3] * fac); pw.z = cvtpk(s0[8 * s + 4] * fac, s0[8 * s + 5] * fac); pw.w = cvtpk(s0[8 * s + 6] * fac, s0[8 * s + 7] * fac); }
            else         { pw.x = cvtpk(s1[8 * s + 0] * fac, s1[8 * s + 1] * fac); pw.y = cvtpk(s1[8 * s + 2] * fac, s1[8 * s + 3] * fac); pw.z = cvtpk(s1[8 * s + 4] * fac, s1[8 * s + 5] * fac); pw.w = cvtpk(s1[8 * s + 6] * fac, s1[8 * s + 7] * fac); }
            const bf16x8 pk = __builtin_bit_cast(bf16x8, pw);
            const int krow = 32 * hf + 16 * mb + 8 * s + tq;
            { const s16x4 vlo = trrd(Vb + krow * SB_VP + (16 * g1 + 4 * tp) * 2), vhi = trrd(Vb + (krow + 4) * SB_VP + (16 * g1 + 4 * tp) * 2);
              o0 = MFMA32(cat8(vlo, vhi), pk, o0); }
            { const s16x4 vlo = trrd(Vb + krow * SB_VP + (32 + 16 * g1 + 4 * tp) * 2), vhi = trrd(Vb + (krow + 4) * SB_VP + (32 + 16 * g1 + 4 * tp) * 2);
              o1 = MFMA32(cat8(vlo, vhi), pk, o1); }
        }
}
__device__ __forceinline__ void sb_phase(LAS unsigned char* L, const bf16_t* Qp, const bf16_t* Kp, const bf16_t* Vp, bf16_t* Op) {
    const int tid = opaque_tid(), lane = tid & 63, w = __builtin_amdgcn_readfirstlane(tid >> 6), n = lane & 31, hf = lane >> 5, g1 = (lane >> 4) & 1, tq = (lane & 15) >> 2, tp = lane & 3;
    const int pir = 32 * ((n >> 2) & 1) + (n & 3) + 4 * (n >> 3);
    const int sr = tid >> 3, sch = tid & 7;
    LAS unsigned* flags = (LAS unsigned*)(L + SB_FLAG);
    for (int bh = blockIdx.x; bh < 256; bh += gridDim.x) {
        const int b = bh >> 4, h = bh & 15;
        const size_t tb = (size_t)b * SEQ;
        const bf16_t* kcol = Kp + (tb + sr) * 1024 + h * 64 + sch * 8;
        const bf16_t* vcol = Vp + (tb + sr) * 1024 + h * 64 + sch * 8;
        u32x4 kreg[6], vreg[6]; bf16x8 qn[4];
#pragma unroll
        for (int ks = 0; ks < 4; ++ks) qn[ks] = *(const bf16x8*)(Qp + (tb + 256 * 7 + 32 * w + n) * 1024 + h * 64 + 16 * ks + 8 * hf);
        { const int lo = 4 * 7 - 2;
#pragma unroll
          for (int j = 0; j < 6; ++j) { kreg[j] = *(const u32x4*)(kcol + (size_t)(lo + j) * 64 * 1024); vreg[j] = *(const u32x4*)(vcol + (size_t)(lo + j) * 64 * 1024); } }
#pragma unroll 1
        for (int kq = 7; kq >= 0; --kq) {
            int lo = 4 * kq - 2; if (lo < 0) lo = 0;
            const int q0 = 256 * kq + 32 * w, qabs = q0 + n;
            bf16x8 qf[4];
#pragma unroll
            for (int ks = 0; ks < 4; ++ks) qf[ks] = qn[ks];
#pragma unroll
            for (int j = 0; j < 6; ++j) { *(LAS u32x4*)(L + j * SB_KS + sr * SB_KP + sch * 16) = kreg[j]; *(LAS u32x4*)(L + SB_VOFF + j * SB_VS + sr * SB_VP + sch * 16) = vreg[j]; }
            __syncthreads();
            if (kq > 0) { int nlo = 4 * (kq - 1) - 2; if (nlo < 0) nlo = 0; const int ncnt = 4 * (kq - 1) + 4 - nlo;
#pragma unroll
                for (int ks = 0; ks < 4; ++ks) qn[ks] = *(const bf16x8*)(Qp + (tb + 256 * (kq - 1) + 32 * w + n) * 1024 + h * 64 + 16 * ks + 8 * hf);
#pragma unroll
                for (int j = 0; j < 6; ++j) if (j < ncnt) { kreg[j] = *(const u32x4*)(kcol + (size_t)(nlo + j) * 64 * 1024); vreg[j] = *(const u32x4*)(vcol + (size_t)(nlo + j) * 64 * 1024); } }
            f32x16 o0, o1;
#pragma unroll
            for (int i = 0; i < 16; ++i) { o0[i] = 0.f; o1[i] = 0.f; }
            float carry = 1.0f;
            int kt = (q0 + 30) >> 6; bool done = false;
#pragma unroll 1
            for (; kt >= lo; --kt) {
                sb_tile(L + (kt - lo) * SB_KS, L + SB_VOFF + (kt - lo) * SB_VS, qf, o0, o1, carry, kt, q0, qabs, pir, hf, g1, tq, tp);
                if (__all(carry >= SB_STOP)) { done = true; break; }
            }
            bool need = !done && lo > 0;
            if (lane == 0) flags[w] = need ? 1u : 0u;
            __syncthreads();
            int flo = lo;
#pragma unroll 1
            for (;;) {
                unsigned any = 0;
#pragma unroll
                for (int q = 0; q < 8; ++q) any |= flags[q];
                if (!any) break;
                --flo;
                const u32x4 kx = *(const u32x4*)(kcol + (size_t)flo * 64 * 1024), vx = *(const u32x4*)(vcol + (size_t)flo * 64 * 1024);
                __syncthreads();
                *(LAS u32x4*)(L + sr * SB_KP + sch * 16) = kx; *(LAS u32x4*)(L + SB_VOFF + sr * SB_VP + sch * 16) = vx;
                __syncthreads();
                if (need) {
                    sb_tile(L, L + SB_VOFF, qf, o0, o1, carry, flo, q0, qabs, pir, hf, g1, tq, tp);
                    if (__all(carry >= SB_STOP) || flo == 0) need = false;
                }
                if (lane == 0) flags[w] = need ? 1u : 0u;
                __syncthreads();
            }
            bf16_t* orow = Op + (tb + qabs) * 1024 + h * 64;
#pragma unroll
            for (int g4 = 0; g4 < 4; ++g4) {
                u32x2 w0, w1; w0.x = cvtpk(o0[4 * g4], o0[4 * g4 + 1]); w0.y = cvtpk(o0[4 * g4 + 2], o0[4 * g4 + 3]); w1.x = cvtpk(o1[4 * g4], o1[4 * g4 + 1]); w1.y = cvtpk(o1[4 * g4 + 2], o1[4 * g4 + 3]);
                *(u32x2*)(orow + 8 * g4 + 4 * hf) = w0; *(u32x2*)(orow + 32 + 8 * g4 + 4 * hf) = w1;
            }
        }
        __syncthreads();
    }
}

__global__ void __launch_bounds__(512, 2) fwd_kernel(Args a) {
    extern __shared__ __attribute__((aligned(16))) unsigned char lds[];
    LAS unsigned char* L = (LAS unsigned char*)lds;
    cg::grid_group grid = cg::this_grid();
    const int G = gridDim.x, bx = blockIdx.x;
    { unsigned char* ws0 = a.ws; x_pass(a.in[0], (bf16_t*)(ws0 + WS_XB), (float*)(ws0 + WS_RSTD)); }
    conv_weights(a, 0, L);
    unsigned* barw = (unsigned*)(a.ws + WS_BAR);
    volatile LAS unsigned* bst = (volatile LAS unsigned*)(L + LDS_BYTES - 64);
    if (bx == 0) { for (int u = threadIdx.x; u < XCD_BAR_WORDS; u += 512) barw[u] = 0u; }
    if (threadIdx.x < 2) bst[threadIdx.x] = 0u;
    grid.sync();
    const XcdBarrier bar = xcd_barrier_post(barw, bst);
#define GSYNC() xcd_barrier(bar)
#pragma unroll 1
    for (int i = 0; i < 4; ++i) {
        const int j = i >> 1; const bool ret = !(i & 1);
        if (i > 0) { conv_weights(a, i, L); rstd_pass((const float*)(a.ws + WS_SSQ), (float*)(a.ws + WS_RSTD)); GSYNC(); }
        size_t zoff = 0; asm volatile("" : "+s"(zoff)); unsigned char* ws = a.ws + zoff;
        float* ssq = (float*)(ws + WS_SSQ); float* ssqp = (float*)(ws + WS_SSQP); float* rstd = (float*)(ws + WS_RSTD);
        bf16_t* wb = (bf16_t*)(ws + WS_W); bf16_t* xb = (bf16_t*)(ws + WS_XB); bf16_t* act = (bf16_t*)(ws + WS_ACT);
        bf16_t* W_mi = wb + W_MI / 2; bf16_t* W_mo = wb + W_MO / 2; bf16_t* W_fi = wb + W_FI / 2; bf16_t* W_fo = wb + W_FO / 2;
        const bf16_t* moA; int moK;
        if (ret) {
            { pg8::Gemm g{xb, W_mi, MTOK, 6144, 1024}; pg8::StaticOrder S; S.init(MTOK, 6144, G, bx);
              pg8::EpiRetProj E{act, rstd};
              pg8::gemm_phase<pg8::EpiRetProj, pg8::StaticOrder, true, true>(L, g, S, E); }
            GSYNC();
            ret_phase(L, act, act + (size_t)MTOK * 1024, act + (size_t)MTOK * 2048, act + (size_t)MTOK * 4096, ssqp);
            GSYNC();
            moA = act + (size_t)MTOK * 2048; moK = 2048;
        } else {
            { pg8::Gemm g{xb, W_mi, MTOK, 3072, 1024}; pg8::StaticOrder S; S.init(MTOK, 3072, G, bx);
              pg8::EpiSbProj E{act, rstd, a.in[7] + j * 64, a.in[8] + j * 64};
              pg8::gemm_phase<pg8::EpiSbProj, pg8::StaticOrder, true, true>(L, g, S, E); }
            GSYNC();
            sb_phase(L, act, act + (size_t)MTOK * 1024, act + (size_t)MTOK * 2048, act + (size_t)MTOK * 3072);
            GSYNC();
            moA = act + (size_t)MTOK * 3072; moK = 1024;
        }
        if (ret) { pg8::Gemm g{moA, W_mo, MTOK, 1024, moK}; pg8::StaticOrder S; S.init(MTOK, 1024, G, bx);
          pg8::EpiResid<true> E{nullptr, xb, ssq, ssqp};
          pg8::gemm_phase<pg8::EpiResid<true>, pg8::StaticOrder, true, true>(L, g, S, E); }
        else { pg8::Gemm g{moA, W_mo, MTOK, 1024, moK}; pg8::StaticOrder S; S.init(MTOK, 1024, G, bx);
          pg8::EpiResid<false> E{nullptr, xb, ssq, nullptr};
          pg8::gemm_phase<pg8::EpiResid<false>, pg8::StaticOrder, true, true>(L, g, S, E); }
        GSYNC();
        rstd_pass(ssq, rstd);
        GSYNC();
        { pg8::Gemm g{xb, W_fi, MTOK, 2 * FFH, 1024}; pg8::StaticOrder S; S.init(MTOK, 2 * FFH, G, bx);
          pg8::EpiFfnIn E{act, rstd};
          pg8::gemm_phase<pg8::EpiFfnIn, pg8::StaticOrder, true, true>(L, g, S, E); }
        GSYNC();
        { pg8::Gemm g{act, W_fo, MTOK, 1024, FFH}; pg8::StaticOrder S; S.init(MTOK, 1024, G, bx);
          pg8::EpiResid<false> E{(i < 3) ? nullptr : a.out, xb, ssq, nullptr};
          pg8::gemm_phase<pg8::EpiResid<false>, pg8::StaticOrder, true, true>(L, g, S, E); }
        if (i < 3) GSYNC();
    }
}

extern "C" void kernel_launch(void* const* d_in, const int* in_sizes, int n_in, void* d_out, int out_size, void* d_ws, size_t ws_size, hipStream_t stream) {
    static int grid_blocks = 0;
    if (grid_blocks == 0) {
        if (n_in != 12 || out_size != MTOK * DM || ws_size < WS_END) { fprintf(stderr, "kernel_launch: unexpected shapes (n_in %d out %d ws %zu)\n", n_in, out_size, ws_size); grid_blocks = -1; return; }
        int dev = 0, cus = 0, per_cu = 0;
        (void)hipGetDevice(&dev);
        (void)hipDeviceGetAttribute(&cus, hipDeviceAttributeMultiprocessorCount, dev);
        (void)hipFuncSetAttribute((const void*)fwd_kernel, hipFuncAttributeMaxDynamicSharedMemorySize, LDS_BYTES);
        (void)hipOccupancyMaxActiveBlocksPerMultiprocessor(&per_cu, (const void*)fwd_kernel, 512, LDS_BYTES);
        if (per_cu < 1) per_cu = 1;
        grid_blocks = cus * per_cu;
    }
    if (grid_blocks < 0) return;
    Args a{};
    for (int i = 0; i < 12; ++i) a.in[i] = (const float*)d_in[i];
    a.out = (float*)d_out; a.ws = (unsigned char*)d_ws;
    void* args[] = {&a};
    hipError_t e = hipLaunchCooperativeKernel((const void*)fwd_kernel, dim3(grid_blocks), dim3(512), args, LDS_BYTES, stream);
    if (e != hipSuccess) fprintf(stderr, "cooperative launch failed: %s (grid %d)\n", hipGetErrorString(e), grid_blocks);
}
```

```cpp
#include <hip/hip_runtime.h>
#include <hip/hip_cooperative_groups.h>
#include <cstdio>
#include <cstdint>
namespace cg = cooperative_groups;
constexpr int MTOK = 32768, DM = 1024, SEQ = 2048, FFH = 2816;
constexpr float EPSN = 1e-6f;
constexpr float C2SB = 0.125f * 1.4426950408889634f;
__device__ __forceinline__ int opaque_tid() { int t = threadIdx.x; asm volatile("" : "+v"(t)); return t; }
namespace pg8 {
#define PG8_LAS __attribute__((address_space(3)))
typedef unsigned short bf16_t;
typedef short bf16x8 __attribute__((ext_vector_type(8)));
typedef float f32x4 __attribute__((ext_vector_type(4)));
typedef unsigned u32x4 __attribute__((ext_vector_type(4)));
constexpr int BM = 256, BK = 64, HALF = 128, HTB = HALF * BK * 2  , STAGE_BYTES = 8 * HTB, NXCD = 8, WGM = 8;

__host__ __device__ __forceinline__ int lds_byte(int r, int c) { const int st = (r >> 4) * 2 + (c >> 5), rr = r & 15, cc = c & 31, ob = rr * 64 + cc * 2; return st * 1024 + (ob ^ (((ob >> 9) & 1) << 5)); }
__host__ __device__ __forceinline__ void stage_rc(int b, int& R, int& C) { const int st = b / 1024, sb = b % 1024, swz = sb ^ (((sb >> 9) & 1) << 5); R = (st >> 1) * 16 + swz / 64; C = (st & 1) * 32 + (swz % 64) / 2; }
__host__ __device__ __forceinline__ int perm32(int rho) { const int n = rho >> 4, i = rho & 15; return 8 * (i >> 2) + 4 * n + (i & 3); }

struct Unit { int pm, pn; };
struct Gemm { const bf16_t* A; const bf16_t* Bt; int M, N, K; };

struct StaticOrder {
    int nM, nN, nwg, G, c;
    __host__ __device__ void init(int M, int N, int G_, int c_) { nM = M / BM; nN = N / BM; nwg = nM * nN; G = G_; c = c_; }
    __host__ __device__ bool next(int i, Unit& u) const {
        const long L = (long)i * G + c; if (L >= nwg) return false;
        int wgid = (int)L; { const int q = nwg / NXCD, r = nwg % NXCD, xcd = wgid % NXCD, off = wgid / NXCD; wgid = (xcd < r ? xcd * (q + 1) : r * (q + 1) + (xcd - r) * q) + off; }
        const int nig = WGM * nN, gid = wgid / nig, fm = gid * WGM, gsz = (nM - fm) < WGM ? (nM - fm) : WGM;
        u.pm = fm + ((wgid % nig) % gsz); u.pn = (wgid % nig) / gsz; return true;
    }
    __device__ __forceinline__ void a_ready(const Unit&) const {}
    __device__ __forceinline__ void done(const Unit&) const {}
};

__device__ __forceinline__ unsigned cvt_pk_bf16(float lo, float hi) { unsigned r; asm volatile("v_cvt_pk_bf16_f32 %0, %1, %2" : "=v"(r) : "v"(lo), "v"(hi)); return r; }
template <class Epi, class Sched, bool ALIGN_EPI = false, bool SP2 = false>
__device__ __forceinline__ void gemm_phase(PG8_LAS unsigned char* lds, const Gemm g, const Sched& S, const Epi& E) {
    const int tid = opaque_tid(), wid = __builtin_amdgcn_readfirstlane(tid >> 6), lane = tid & 63, wr = wid >> 2, wc = wid & 3, fr = lane & 15, fq = lane >> 4;
    const int K = g.K, nt = K / BK;
    unsigned voffA[2], voffB[2];
#pragma unroll
    for (int i = 0; i < 2; ++i) { int R, C; stage_rc(tid * 16 + i * 8192, R, C); const int Rb = Epi::PERM ? ((R & ~31) + perm32(R & 31)) : R;
        voffA[i] = (unsigned)(R * K + C) * 2u; voffB[i] = (unsigned)(Rb * K + C) * 2u; }
    const size_t kstep = (size_t)(BK * 2);
    const size_t hstep = (size_t)HALF * K * 2;
    const size_t tstep = 2 * hstep;
    const unsigned ldsw = (unsigned)wid * 1024u;
    const int aoff = lds_byte(wr * 64 + fr, fq * 8), boff = lds_byte(wc * 32 + fr, fq * 8);
#define PG8_SA(b, h) (((b) * 2 + (h)) * HTB)
#define PG8_SB(b, h) ((4 + (b) * 2 + (h)) * HTB)
#define PG8_STAGE(bufoff, gbase, voff) do { _Pragma("unroll") for (int _i = 0; _i < 2; ++_i) \
        __builtin_amdgcn_global_load_lds((const unsigned*)((const char*)(gbase) + (voff)[_i]), (PG8_LAS unsigned*)(lds + (bufoff) + ldsw + _i * 8192), 16, 0, 0); } while (0)
#define PG8_LDA(dst, b, h) do { _Pragma("unroll") for (int m = 0; m < 4; ++m) _Pragma("unroll") for (int k = 0; k < 2; ++k) dst[m][k] = *(const PG8_LAS bf16x8*)(lds + PG8_SA(b, h) + aoff + m * 2048 + k * 1024); } while (0)
#define PG8_LDB(dst, b, h) do { _Pragma("unroll") for (int n = 0; n < 2; ++n) _Pragma("unroll") for (int k = 0; k < 2; ++k) dst[n][k] = *(const PG8_LAS bf16x8*)(lds + PG8_SB(b, h) + boff + n * 2048 + k * 1024); } while (0)
#define PG8_MMA(ai, bj, At, Bt) do { __builtin_amdgcn_s_setprio(1); _Pragma("unroll") for (int m = 0; m < 4; ++m) _Pragma("unroll") for (int n = 0; n < 2; ++n) _Pragma("unroll") for (int k = 0; k < 2; ++k) \
        acc[ai][bj][m][n] = __builtin_amdgcn_mfma_f32_16x16x32_bf16(Bt[n][k], At[m][k], acc[ai][bj][m][n], 0, 0, 0); __builtin_amdgcn_s_setprio(0); } while (0)
#define PG8_WAIT_V(n) asm volatile("s_waitcnt vmcnt(" #n ")" ::: "memory")
#define PG8_WAIT_L(n) asm volatile("s_waitcnt lgkmcnt(" #n ")" ::: "memory")
#define PG8_BAR __builtin_amdgcn_s_barrier()
#define PG8_SCHED __builtin_amdgcn_sched_barrier(0)
    Unit cur, nxt; int ui = 0;
    float rowc[8]; int rowc_pm = -1;
#pragma unroll
    for (int q = 0; q < 8; ++q) rowc[q] = 0.f;
    if (!S.next(0, cur)) return;
    f32x4 acc[2][2][4][2];
#pragma unroll
    for (int a = 0; a < 2; ++a)
#pragma unroll
        for (int b = 0; b < 2; ++b)
#pragma unroll
            for (int m = 0; m < 4; ++m)
#pragma unroll
                for (int n = 0; n < 2; ++n) acc[a][b][m][n] = (f32x4){0.f, 0.f, 0.f, 0.f};
    bf16x8 At[4][2], B0[2][2], B1[2][2];
    const char* cA = (const char*)g.A + (size_t)cur.pm * tstep; const char* cB = (const char*)g.Bt + (size_t)cur.pn * tstep;
    S.a_ready(cur);
    if constexpr (SP2) {
        PG8_STAGE(PG8_SB(0, 0), cB, voffB); PG8_STAGE(PG8_SB(0, 1), cB + hstep, voffB); PG8_STAGE(PG8_SA(0, 0), cA, voffA); PG8_STAGE(PG8_SA(0, 1), cA + hstep, voffA);
        if (wr == 1) PG8_BAR;
        PG8_WAIT_V(2); PG8_BAR;
        PG8_STAGE(PG8_SB(1, 0), cB + kstep, voffB); PG8_STAGE(PG8_SA(1, 0), cA + kstep, voffA); PG8_STAGE(PG8_SB(1, 1), cB + hstep + kstep, voffB);
        PG8_WAIT_V(6); PG8_BAR;
    } else {
        PG8_STAGE(PG8_SB(0, 0), cB, voffB); PG8_STAGE(PG8_SA(0, 0), cA, voffA); PG8_STAGE(PG8_SB(0, 1), cB + hstep, voffB); PG8_STAGE(PG8_SA(0, 1), cA + hstep, voffA);
        if (wr == 1) PG8_BAR;
        PG8_WAIT_V(4); PG8_BAR;
        PG8_STAGE(PG8_SB(1, 0), cB + kstep, voffB); PG8_STAGE(PG8_SA(1, 0), cA + kstep, voffA); PG8_STAGE(PG8_SB(1, 1), cB + hstep + kstep, voffB);
        PG8_WAIT_V(6); PG8_BAR;
    }
    for (;;) {
        const bool has_next = S.next(ui + 1, nxt);
        const char* nA = has_next ? (const char*)g.A + (size_t)nxt.pm * tstep : cA; const char* nB = has_next ? (const char*)g.Bt + (size_t)nxt.pn * tstep : cB;
        for (int t = 0; t < nt; t += 2) {
            const bool last = (t == nt - 2);
            const char* a1 = cA + (size_t)(t + 1) * kstep;
            const char* a2 = last ? nA : cA + (size_t)(t + 2) * kstep; const char* b2 = last ? nB : cB + (size_t)(t + 2) * kstep;
            const char* a3 = a2 + kstep; const char* b3 = b2 + kstep;
            if (last && has_next) S.a_ready(nxt);
            if constexpr (SP2) {
            PG8_LDB(B0, 0, 0); PG8_LDB(B1, 0, 1); PG8_SCHED; PG8_LDA(At, 0, 0); PG8_STAGE(PG8_SA(1, 1), a1 + hstep, voffA);
            PG8_WAIT_V(8); PG8_WAIT_L(0); PG8_BAR; PG8_MMA(0, 0, At, B0); PG8_MMA(0, 1, At, B1); PG8_BAR; PG8_SCHED;
            PG8_LDA(At, 0, 1); PG8_STAGE(PG8_SB(0, 0), b2, voffB); PG8_STAGE(PG8_SB(0, 1), b2 + hstep, voffB); PG8_STAGE(PG8_SA(0, 0), a2, voffA);
            PG8_WAIT_V(8); PG8_WAIT_L(0); PG8_BAR; PG8_MMA(1, 0, At, B0); PG8_MMA(1, 1, At, B1); PG8_BAR; PG8_SCHED;
            PG8_LDB(B0, 1, 0); PG8_LDB(B1, 1, 1); PG8_SCHED; PG8_LDA(At, 1, 0); PG8_STAGE(PG8_SA(0, 1), a2 + hstep, voffA);
            PG8_WAIT_V(8); PG8_WAIT_L(0); PG8_BAR; PG8_MMA(0, 0, At, B0); PG8_MMA(0, 1, At, B1); PG8_BAR; PG8_SCHED;
            PG8_LDA(At, 1, 1); PG8_STAGE(PG8_SB(1, 0), b3, voffB); PG8_STAGE(PG8_SB(1, 1), b3 + hstep, voffB); PG8_STAGE(PG8_SA(1, 0), a3, voffA);
            PG8_WAIT_V(8); PG8_WAIT_L(0); PG8_BAR; PG8_MMA(1, 0, At, B0); PG8_MMA(1, 1, At, B1); PG8_BAR; PG8_SCHED;
            } else {
            PG8_LDB(B0, 0, 0); PG8_SCHED; PG8_LDA(At, 0, 0); PG8_STAGE(PG8_SA(1, 1), a1 + hstep, voffA);
            PG8_WAIT_L(8); PG8_BAR; PG8_WAIT_L(0); PG8_MMA(0, 0, At, B0); PG8_BAR; PG8_SCHED;
            PG8_LDB(B1, 0, 1); PG8_STAGE(PG8_SB(0, 0), b2, voffB);
            PG8_BAR; PG8_WAIT_L(0); PG8_MMA(0, 1, At, B1); PG8_BAR;
            PG8_LDA(At, 0, 1); PG8_STAGE(PG8_SA(0, 0), a2, voffA);
            PG8_BAR; PG8_WAIT_L(0); PG8_MMA(1, 0, At, B0); PG8_BAR; PG8_SCHED;
            PG8_STAGE(PG8_SB(0, 1), b2 + hstep, voffB);
            PG8_WAIT_V(6); PG8_BAR; PG8_MMA(1, 1, At, B1); PG8_BAR;
            PG8_LDB(B0, 1, 0); PG8_SCHED; PG8_LDA(At, 1, 0); PG8_STAGE(PG8_SA(0, 1), a2 + hstep, voffA);
            PG8_WAIT_L(8); PG8_BAR; PG8_WAIT_L(0); PG8_MMA(0, 0, At, B0); PG8_BAR; PG8_SCHED;
            PG8_LDB(B1, 1, 1); PG8_STAGE(PG8_SB(1, 0), b3, voffB);
            PG8_BAR; PG8_WAIT_L(0); PG8_MMA(0, 1, At, B1); PG8_BAR;
            PG8_LDA(At, 1, 1); PG8_STAGE(PG8_SA(1, 0), a3, voffA);
            PG8_BAR; PG8_WAIT_L(0); PG8_MMA(1, 0, At, B0); PG8_BAR; PG8_SCHED;
            PG8_STAGE(PG8_SB(1, 1), b3 + hstep, voffB);
            PG8_WAIT_V(6); PG8_BAR; PG8_MMA(1, 1, At, B1); PG8_BAR;
            }
            if constexpr (Epi::HEAD_HOOK) { if (E.hook_on() && ((t + 2) & 7) == 0 && !last) { E.rescale(acc, cur, wr, fr, (t + 2) >> 3); PG8_SCHED; } }
        }
        if constexpr (ALIGN_EPI) { if (wr == 0) PG8_BAR; }
        if constexpr (!Epi::AFTER_DRAIN) { E(acc, cur, wr, wc, fr, fq, rowc, rowc_pm); S.done(cur); }
        if (!has_next) break;
#pragma unroll
        for (int a = 0; a < 2; ++a)
#pragma unroll
            for (int b = 0; b < 2; ++b)
#pragma unroll
                for (int m = 0; m < 4; ++m)
#pragma unroll
                    for (int n = 0; n < 2; ++n) acc[a][b][m][n] = (f32x4){0.f, 0.f, 0.f, 0.f};
        cur = nxt; cA = nA; cB = nB; ++ui;
        if constexpr (ALIGN_EPI) { if (wr == 1) PG8_BAR; }
    }
    PG8_WAIT_V(0);
    if constexpr (!ALIGN_EPI) { if (wr == 0) PG8_BAR; }
    PG8_BAR;
    if constexpr (Epi::AFTER_DRAIN) { E.fused(acc, cur, wr, wc, fr, fq, lds, wid, lane); S.done(cur); }
#undef PG8_SA
#undef PG8_SB
#undef PG8_STAGE
#undef PG8_LDA
#undef PG8_LDB
#undef PG8_MMA
#undef PG8_WAIT_V
#undef PG8_WAIT_L
#undef PG8_BAR
#undef PG8_SCHED
}
typedef float f32x2_t __attribute__((ext_vector_type(2))); typedef __bf16 bf16x2_t __attribute__((ext_vector_type(2)));
__device__ __forceinline__ unsigned cvtpk(float lo, float hi) { f32x2_t v = {lo, hi}; bf16x2_t b = __builtin_convertvector(v, bf16x2_t); return __builtin_bit_cast(unsigned, b); }
__device__ __forceinline__ float bflo(unsigned u) { return __uint_as_float(u << 16); }
__device__ __forceinline__ float bfhi(unsigned u) { return __uint_as_float(u & 0xffff0000u); }
__device__ __forceinline__ float row_rstd(const float* rstd, int row) { return rstd[row]; }
__device__ __forceinline__ void row_rstd8(const float* rstd, int row0, float (&rs)[8]) {
#pragma unroll
    for (int q = 0; q < 8; ++q) rs[q] = rstd[row0 + (q >> 2) * HALF + (q & 3) * 16];
}

struct EpiRetProj {
    static constexpr bool PERM = true, AFTER_DRAIN = false, HEAD_HOOK = false;
    bf16_t* act; const float* ssq;
    __device__ __forceinline__ void operator()(const f32x4 (&acc)[2][2][4][2], const Unit& u, int wr, int wc, int fr_, int fq_, float (&rs8)[8], int& rs_pm) const {
        int fr = fr_, fq = fq_; asm volatile("" : "+v"(fr), "+v"(fq));
        const int row0 = u.pm * BM + wr * 64 + fr; const int pn = u.pn;
        if (u.pm != rs_pm) { row_rstd8(ssq, row0, rs8); rs_pm = u.pm; }
        if (pn < 8) {
            const int head = pn & 3; const bool isk = pn >= 4;
            bf16_t* plane = act + (isk ? (size_t)MTOK * 1024 : (size_t)0);
            const float osc = isk ? 0.0625f : 1.0f;
            float invf[8];
#pragma unroll
            for (int q = 0; q < 8; ++q) { const int i = wc * 32 + 8 * fq + q; invf[q] = __builtin_amdgcn_exp2f(-(float)i * (13.287712379549449f / 128.0f)) * 0.15915494309189535f; }
#pragma unroll
            for (int ai = 0; ai < 2; ++ai)
#pragma unroll
                for (int m = 0; m < 4; ++m) {
                    const int row = row0 + ai * HALF + m * 16; const float rstd = rs8[ai * 4 + m]; const float pos = (float)(row & (SEQ - 1));
                    float o1[8], o2[8];
#pragma unroll
                    for (int q = 0; q < 8; ++q) {
                        const float rev = __builtin_amdgcn_fractf(pos * invf[q]);
                        const float sn = __builtin_amdgcn_sinf(rev), cs = __builtin_amdgcn_cosf(rev);
                        const float x1 = acc[ai][0][m][q >> 2][q & 3] * rstd, x2 = acc[ai][1][m][q >> 2][q & 3] * rstd;
                        o1[q] = (x1 * cs - x2 * sn) * osc; o2[q] = (x1 * sn + x2 * cs) * osc;
                    }
                    bf16_t* rp = plane + (size_t)row * 1024 + head * 256 + wc * 32 + 8 * fq;
                    u32x4 w1, w2;
                    w1.x = cvtpk(o1[0], o1[1]); w1.y = cvtpk(o1[2], o1[3]); w1.z = cvtpk(o1[4], o1[5]); w1.w = cvtpk(o1[6], o1[7]);
                    w2.x = cvtpk(o2[0], o2[1]); w2.y = cvtpk(o2[2], o2[3]); w2.z = cvtpk(o2[4], o2[5]); w2.w = cvtpk(o2[6], o2[7]);
                    *(u32x4*)rp = w1; *(u32x4*)(rp + 128) = w2;
                    asm volatile("" ::: "memory");
                }
        } else {
            const bool isg = pn >= 16; const int t = isg ? pn - 16 : pn - 8;
            bf16_t* plane = act + (size_t)MTOK * (isg ? 4096 : 2048);
#pragma unroll
            for (int ai = 0; ai < 2; ++ai)
#pragma unroll
                for (int m = 0; m < 4; ++m) {
                    const int row = row0 + ai * HALF + m * 16; const float rstd = rs8[ai * 4 + m];
                    bf16_t* rp = plane + (size_t)row * 2048 + t * 256 + wc * 32 + 8 * fq;
#pragma unroll
                    for (int bj = 0; bj < 2; ++bj) { f32x4 v0 = acc[ai][bj][m][0] * rstd, v1 = acc[ai][bj][m][1] * rstd;
                        if (isg) {
#pragma unroll
                            for (int e = 0; e < 4; ++e) { v0[e] *= __builtin_amdgcn_rcpf(1.0f + __builtin_amdgcn_exp2f(-1.4426950408889634f * v0[e])); v1[e] *= __builtin_amdgcn_rcpf(1.0f + __builtin_amdgcn_exp2f(-1.4426950408889634f * v1[e])); }
                        }
                        u32x4 w; w.x = cvtpk(v0[0], v0[1]); w.y = cvtpk(v0[2], v0[3]); w.z = cvtpk(v1[0], v1[1]); w.w = cvtpk(v1[2], v1[3]);
                        *(u32x4*)(rp + bj * HALF) = w; }
                    asm volatile("" ::: "memory");
                }
        }
    }
};

struct EpiSbProj {
    static constexpr bool PERM = true, AFTER_DRAIN = false, HEAD_HOOK = false;
    bf16_t* act; const float* ssq; const float* qg; const float* kg;
    __device__ __forceinline__ void operator()(const f32x4 (&acc)[2][2][4][2], const Unit& u, int wr, int wc, int fr_, int fq_, float (&rs8)[8], int& rs_pm) const {
        int fr = fr_, fq = fq_; asm volatile("" : "+v"(fr), "+v"(fq));
        const int row0 = u.pm * BM + wr * 64 + fr; const int which = u.pn >> 2, t = u.pn & 3;
        if (u.pm != rs_pm) { row_rstd8(ssq, row0, rs8); rs_pm = u.pm; }
        bf16_t* plane = act + (size_t)which * MTOK * 1024;
        const int colbase = t * 256 + 64 * wc + 8 * fq;
        float g[2][8];
        if (which < 2) { const float* gp = which == 0 ? qg : kg; const float gs = which == 0 ? C2SB : 1.0f;
#pragma unroll
            for (int bj = 0; bj < 2; ++bj)
#pragma unroll
                for (int q = 0; q < 8; ++q) g[bj][q] = gp[32 * bj + 8 * fq + q] * gs;
        }
#pragma unroll
        for (int ai = 0; ai < 2; ++ai)
#pragma unroll
            for (int m = 0; m < 4; ++m) {
                const int row = row0 + ai * HALF + m * 16; const float rstd = rs8[ai * 4 + m];
                float v[2][8];
#pragma unroll
                for (int bj = 0; bj < 2; ++bj)
#pragma unroll
                    for (int q = 0; q < 8; ++q) v[bj][q] = acc[ai][bj][m][q >> 2][q & 3] * rstd;
                if (which < 2) {
                    float ss = 0.f;
#pragma unroll
                    for (int bj = 0; bj < 2; ++bj)
#pragma unroll
                        for (int q = 0; q < 8; ++q) ss += v[bj][q] * v[bj][q];
                    ss += __shfl_xor(ss, 16); ss += __shfl_xor(ss, 32);
                    const float rn = rsqrtf(ss * (1.0f / 64.0f) + EPSN);
#pragma unroll
                    for (int bj = 0; bj < 2; ++bj)
#pragma unroll
                        for (int q = 0; q < 8; ++q) v[bj][q] = v[bj][q] * rn * g[bj][q];
                }
                bf16_t* rp = plane + (size_t)row * 1024 + colbase;
#pragma unroll
                for (int bj = 0; bj < 2; ++bj) { u32x4 w; w.x = cvtpk(v[bj][0], v[bj][1]); w.y = cvtpk(v[bj][2], v[bj][3]); w.z = cvtpk(v[bj][4], v[bj][5]); w.w = cvtpk(v[bj][6], v[bj][7]);
                    *(u32x4*)(rp + 32 * bj) = w; }
                asm volatile("" ::: "memory");
            }
    }
};

struct EpiFfnIn {
    static constexpr bool PERM = true, AFTER_DRAIN = false, HEAD_HOOK = false;
    bf16_t* hbuf; const float* ssq;
    __device__ __forceinline__ void operator()(const f32x4 (&acc)[2][2][4][2], const Unit& u, int wr, int wc, int fr_, int fq_, float (&rs8)[8], int& rs_pm) const {
        int fr = fr_, fq = fq_; asm volatile("" : "+v"(fr), "+v"(fq));
        const int row0 = u.pm * BM + wr * 64 + fr;
        if (u.pm != rs_pm) { row_rstd8(ssq, row0, rs8); rs_pm = u.pm; }
#pragma unroll
        for (int ai = 0; ai < 2; ++ai)
#pragma unroll
            for (int m = 0; m < 4; ++m) {
                const int row = row0 + ai * HALF + m * 16; const float rstd = rs8[ai * 4 + m];
                float hv[8];
#pragma unroll
                for (int q = 0; q < 8; ++q) { const float gt = acc[ai][0][m][q >> 2][q & 3] * rstd, up = acc[ai][1][m][q >> 2][q & 3] * rstd;
                    hv[q] = gt * __builtin_amdgcn_rcpf(1.0f + __builtin_amdgcn_exp2f(-1.4426950408889634f * gt)) * up; }
                u32x4 w; w.x = cvtpk(hv[0], hv[1]); w.y = cvtpk(hv[2], hv[3]); w.z = cvtpk(hv[4], hv[5]); w.w = cvtpk(hv[6], hv[7]);
                *(u32x4*)(hbuf + (size_t)row * FFH + u.pn * 128 + wc * 32 + 8 * fq) = w;
                asm volatile("" ::: "memory");
            }
    }
};

struct EpiResid {
    static constexpr bool PERM = true, AFTER_DRAIN = false, HEAD_HOOK = true;
    float* out;
    bf16_t* xb; float* ssq;
    const float* hss;
    __device__ __forceinline__ bool hook_on() const { return hss != nullptr; }
    __device__ __forceinline__ float head_rstd(int row, int h) const {
        const f32x4 sp = *(const f32x4*)(hss + (size_t)row * 16 + h * 4);
        return rsqrtf(((sp[0] + sp[1]) + (sp[2] + sp[3])) * (1.0f / 512.0f) + EPSN);
    }
    __device__ __forceinline__ void rescale(f32x4 (&acc)[2][2][4][2], const Unit& u, int wr, int fr_, int hnext) const {
        int fr = fr_; asm volatile("" : "+v"(fr));
        const float* hp = hss + (size_t)(u.pm * BM + wr * 64 + fr) * 16 + (hnext - 1) * 4;
#pragma unroll
        for (int half = 0; half < 2; ++half) {
            f32x4 s0[4], s1[4];
#pragma unroll
            for (int m = 0; m < 4; ++m) { const float* p = hp + (size_t)(half * HALF + m * 16) * 16; s0[m] = *(const f32x4*)p; s1[m] = *(const f32x4*)(p + 4); }
#pragma unroll
            for (int m = 0; m < 4; ++m) {
                const float a = ((s0[m][0] + s0[m][1]) + (s0[m][2] + s0[m][3])) * (1.0f / 512.0f) + EPSN, b = ((s1[m][0] + s1[m][1]) + (s1[m][2] + s1[m][3])) * (1.0f / 512.0f) + EPSN;
                const float r = sqrtf(b * __builtin_amdgcn_rcpf(a));
#pragma unroll
                for (int bj = 0; bj < 2; ++bj) { acc[half][bj][m][0] = acc[half][bj][m][0] * r; acc[half][bj][m][1] = acc[half][bj][m][1] * r; }
            }
        }
    }
    __device__ __forceinline__ void operator()(const f32x4 (&acc)[2][2][4][2], const Unit& u, int wr, int wc, int fr_, int fq_, float (&rs8)[8], int& rs_pm) const {
        int fr = fr_, fq = fq_; asm volatile("" : "+v"(fr), "+v"(fq));
        const int row0 = u.pm * BM + wr * 64 + fr;
        const size_t coff = (size_t)u.pn * BM + wc * 32 + 8 * fq;
#pragma unroll
        for (int half = 0; half < 2; ++half) {
            u32x4 nb[4][2]; float fsv[4];
#pragma unroll
            for (int m = 0; m < 4; ++m) { const int row = row0 + half * HALF + m * 16; const bf16_t* bp = xb + (size_t)row * DM + coff;
                nb[m][0] = *(const u32x4*)bp; nb[m][1] = *(const u32x4*)(bp + HALF); fsv[m] = hss ? head_rstd(row, 3) : 1.0f; }
#pragma unroll
            for (int m = 0; m < 4; ++m) {
                const int row = row0 + half * HALF + m * 16; float s = 0.f; const float fs = fsv[m];
#pragma unroll
                for (int bj = 0; bj < 2; ++bj) {
                    const size_t off = (size_t)row * DM + coff + bj * HALF;
                    const u32x4 cb = nb[m][bj];
                    const f32x4 b0 = (f32x4){bflo(cb.x), bfhi(cb.x), bflo(cb.y), bfhi(cb.y)}, b1 = (f32x4){bflo(cb.z), bfhi(cb.z), bflo(cb.w), bfhi(cb.w)};
                    const f32x4 v0 = b0 + acc[half][bj][m][0] * fs, v1 = b1 + acc[half][bj][m][1] * fs;
                    if (out) { *(f32x4*)(out + off) = v0; *(f32x4*)(out + off + 4) = v1; }
                    else {
                        u32x4 w; w.x = cvtpk(v0[0], v0[1]); w.y = cvtpk(v0[2], v0[3]); w.z = cvtpk(v1[0], v1[1]); w.w = cvtpk(v1[2], v1[3]);
                        *(u32x4*)(xb + off) = w;
                        s += (v0[0] * v0[0] + v0[1] * v0[1]) + (v0[2] * v0[2] + v0[3] * v0[3]) + (v1[0] * v1[0] + v1[1] * v1[1]) + (v1[2] * v1[2] + v1[3] * v1[3]);
                    }
                }
                if (!out) { s += __shfl_xor(s, 16); s += __shfl_xor(s, 32); if (fq == 0) ssq[(size_t)row * 16 + u.pn * 4 + wc] = s; }
            }
            asm volatile("" ::: "memory");
        }
    }
};
}

#define LAS __attribute__((address_space(3)))
typedef unsigned short bf16_t;
typedef short bf16x8 __attribute__((ext_vector_type(8)));
typedef short s16x4 __attribute__((ext_vector_type(4)));
typedef float f32x4 __attribute__((ext_vector_type(4)));
typedef float f32x16 __attribute__((ext_vector_type(16)));
typedef unsigned u32x4 __attribute__((ext_vector_type(4)));
typedef unsigned u32x2 __attribute__((ext_vector_type(2)));
using pg8::cvtpk; using pg8::bflo; using pg8::bfhi;
#define MFMA16(a, b, c) __builtin_amdgcn_mfma_f32_16x16x32_bf16((a), (b), (c), 0, 0, 0)
#define MFMA32(a, b, c) __builtin_amdgcn_mfma_f32_32x32x16_bf16((a), (b), (c), 0, 0, 0)
__device__ __forceinline__ s16x4 trrd(LAS unsigned char* p) { return __builtin_bit_cast(s16x4, __builtin_amdgcn_ds_read_tr16_b64_v4i16((LAS s16x4*)p)); }
__device__ __forceinline__ bf16x8 cat8(s16x4 lo, s16x4 hi) { return __builtin_shufflevector(lo, hi, 0, 1, 2, 3, 4, 5, 6, 7); }

#define XB_TMO      128
#define XB_XCNT(j)  (256  + 64 * (j))
#define XB_XSUB(j)  (1280 + 64 * (j))
#define XB_XGEN(j)  (2304 + 64 * (j))
#define XB_TOP      3328
#define XB_TOPGEN   3392
#define XCD_BAR_WORDS 3456
#define XB_SPIN_CAP (1u << 18)

__device__ __forceinline__ unsigned xb_ld(unsigned* p)              { return __hip_atomic_load(p, __ATOMIC_RELAXED, __HIP_MEMORY_SCOPE_AGENT); }
__device__ __forceinline__ unsigned xb_add(unsigned* p, unsigned v) { return __hip_atomic_fetch_add(p, v, __ATOMIC_RELAXED, __HIP_MEMORY_SCOPE_AGENT); }
__device__ __forceinline__ unsigned xb_xcc_id() { return (unsigned)__builtin_amdgcn_s_getreg((3 << 11) | 20) & 0xFu; }
#define XB_SPIN(cond, bar) do { unsigned _sp = 0; while (cond) { __builtin_amdgcn_s_sleep(1); \
    if ((++_sp & 255u) == 0u) { if (xb_ld(&(bar)[XB_TMO])) break; if (_sp > XB_SPIN_CAP) { atomicAdd(&(bar)[XB_TMO], 1u); break; } } } } while (0)

struct XcdBarrier {
    unsigned* bar; unsigned x;
    volatile LAS unsigned* st;
};

__device__ __forceinline__ XcdBarrier xcd_barrier_post(unsigned* bar, volatile LAS unsigned* st) {
    XcdBarrier b; b.bar = bar; b.x = xb_xcc_id(); b.st = st;
    if (threadIdx.x == 0) (void)xb_add(&bar[XB_XCNT(b.x)], 1u);
    return b;
}
__device__ __forceinline__ void xcd_barrier_complete(unsigned* bar, unsigned x, unsigned& nloc, unsigned& nx) {
    const unsigned G = gridDim.x * gridDim.y * gridDim.z;
    unsigned sum, cnt, mine, sp = 0u;
    for (;;) {
        sum = 0u; cnt = 0u; mine = 0u;
#pragma unroll
        for (unsigned j = 0; j < 16; ++j) { const unsigned c = xb_ld(&bar[XB_XCNT(j)]); sum += c; cnt += (c > 0u) ? 1u : 0u; mine = (j == x) ? c : mine; }
        if (sum == G) break;
        __builtin_amdgcn_s_sleep(1);
        if ((++sp & 255u) == 0u) { if (xb_ld(&bar[XB_TMO])) break; if (sp > XB_SPIN_CAP) { atomicAdd(&bar[XB_TMO], 1u); break; } }
    }
    nloc = mine > 0u ? mine : 1u; nx = cnt > 0u ? cnt : 1u;
}

__device__ __forceinline__ void xcd_barrier(const XcdBarrier& b) {
    asm volatile("s_waitcnt vmcnt(0)" ::: "memory");
    __syncthreads();
    if (threadIdx.x == 0) {
        unsigned* bar = b.bar;
        __builtin_amdgcn_s_waitcnt(0);
        unsigned nloc = b.st[0], nx = b.st[1];
        if (nloc == 0u) { xcd_barrier_complete(bar, b.x, nloc, nx); b.st[0] = nloc; b.st[1] = nx; }
        const unsigned old = xb_add(&bar[XB_XSUB(b.x)], 1u);
        const unsigned gen = old / nloc;
        if (old + 1u == (gen + 1u) * nloc) {
            __builtin_amdgcn_fence(__ATOMIC_RELEASE, "agent");
            asm volatile("s_waitcnt vmcnt(0)" ::: "memory");
            const unsigned og = xb_add(&bar[XB_TOP], 1u);
            const unsigned tg = og / nx;
            if (og + 1u == (tg + 1u) * nx) xb_add(&bar[XB_TOPGEN], 1u);
            else XB_SPIN(xb_ld(&bar[XB_TOPGEN]) == tg, bar);
            __builtin_amdgcn_fence(__ATOMIC_ACQUIRE, "agent");
            xb_add(&bar[XB_XGEN(b.x)], 1u);
            asm volatile("s_waitcnt vmcnt(0)" ::: "memory");
        } else {
            XB_SPIN(xb_ld(&bar[XB_XGEN(b.x)]) == gen, bar);
            __builtin_amdgcn_fence(__ATOMIC_ACQUIRE, "agent");
            asm volatile("s_waitcnt vmcnt(0)" ::: "memory");
        }
    }
    __syncthreads();
}

constexpr size_t MiB = 1u << 20;
constexpr size_t WS_SSQ = 0;
constexpr size_t WS_SSQP = 2 * MiB;
constexpr size_t WS_W = 4 * MiB;
constexpr size_t W_MI = 0, W_MO = 12 * MiB, W_FI = 16 * MiB, W_FO = 27 * MiB;
constexpr size_t WS_XB = 38 * MiB;
constexpr size_t WS_ACT = 102 * MiB;
constexpr size_t WS_BAR = 486 * MiB;
constexpr size_t WS_RSTD = 486 * MiB + 65536;
constexpr size_t WS_END = 486 * MiB + 65536 + 131072;
constexpr int LDS_BYTES = 147456;

__device__ __forceinline__ int dest_row(int mode, int c) {
    if (mode == 1) { const int pn = c >> 8, l = c & 255; return (pn << 8) + ((l >> 5) & 1) * 128 + (l >> 6) * 32 + (l & 31); }
    if (mode == 2) { const int half = c >= FFH ? 1 : 0; const int hc = c - half * FFH; return ((hc >> 7) << 8) + half * 128 + (hc & 127); }
    return c;
}
__device__ __forceinline__ void transpose_item(const float* W, int K, int N, const float* gain, bf16_t* WT, int mode, LAS float* scr, int item, int lane) {
    const int nblk = N / 64, kb = item / nblk, nb = item % nblk, k0 = 64 * kb, n0 = 64 * nb;
    const int lr = lane >> 4, c4 = (lane & 15) * 4;
#pragma unroll 8
    for (int i = 0; i < 16; ++i) { const int r = 4 * i + lr; const float gv = gain ? gain[k0 + r] : 1.0f;
        const f32x4 v = *(const f32x4*)(W + (size_t)(k0 + r) * N + n0 + c4);
        LAS float* d = scr + r * 65 + c4; d[0] = v[0] * gv; d[1] = v[1] * gv; d[2] = v[2] * gv; d[3] = v[3] * gv; }
    asm volatile("s_waitcnt lgkmcnt(0)" ::: "memory");
    const int c = lane & 7;
#pragma unroll
    for (int j = 0; j < 8; ++j) { const int n = (lane >> 3) + 8 * j; const LAS float* sp = scr + (8 * c) * 65 + n;
        u32x4 o; o.x = cvtpk(sp[0 * 65], sp[1 * 65]); o.y = cvtpk(sp[2 * 65], sp[3 * 65]); o.z = cvtpk(sp[4 * 65], sp[5 * 65]); o.w = cvtpk(sp[6 * 65], sp[7 * 65]);
        *(u32x4*)(WT + (size_t)dest_row(mode, n0 + n) * K + k0 + 8 * c) = o; }
    asm volatile("s_waitcnt lgkmcnt(0)" ::: "memory");
}
struct Args { const float* in[12]; float* out; unsigned char* ws; };
__device__ __forceinline__ void conv_weights(const Args& a, int i, LAS unsigned char* L) {
    const int tid = opaque_tid(), lane = tid & 63, wave = tid >> 6;
    LAS float* scr = (LAS float*)(L + wave * 16640);
    const int gw = blockIdx.x * 8 + wave, NGW = gridDim.x * 8;
    const int j = i >> 1; const bool ret = !(i & 1);
    bf16_t* wbase = (bf16_t*)(a.ws + WS_W);
    const int I_MI = ret ? 16 * 96 : 16 * 48, I_MO = ret ? 32 * 16 : 16 * 16, I_FI = 16 * 88, I_FO = 44 * 16;
    const int total = I_MI + I_MO + I_FI + I_FO;
    for (int it = gw; it < total; it += NGW) {
        int r = it;
        if (r < I_MI) { if (ret) transpose_item(a.in[3] + (size_t)j * 1024 * 6144, 1024, 6144, a.in[1] + i * 1024, wbase + W_MI / 2, 0, scr, r, lane);
                        else     transpose_item(a.in[6] + (size_t)j * 1024 * 3072, 1024, 3072, a.in[1] + i * 1024, wbase + W_MI / 2, 1, scr, r, lane);
                        continue; }
        r -= I_MI;
        if (r < I_MO) { if (ret) transpose_item(a.in[5] + (size_t)j * 2048 * 1024, 2048, 1024, a.in[4] + (size_t)j * 2048, wbase + W_MO / 2, 0, scr, r, lane);
                        else     transpose_item(a.in[9] + (size_t)j * 1024 * 1024, 1024, 1024, nullptr, wbase + W_MO / 2, 0, scr, r, lane);
                        continue; }
        r -= I_MO;
        if (r < I_FI) { transpose_item(a.in[10] + (size_t)i * 1024 * 5632, 1024, 5632, a.in[2] + i * 1024, wbase + W_FI / 2, 2, scr, r, lane); continue; }
        r -= I_FI;
        transpose_item(a.in[11] + (size_t)i * FFH * 1024, FFH, 1024, nullptr, wbase + W_FO / 2, 0, scr, r, lane);
    }
}
__device__ __forceinline__ void x_pass(const float* x, bf16_t* xb, float* rstd) {
    const int tid = opaque_tid(), lane = tid & 63, wave = tid >> 6;
    const int gw = blockIdx.x * 8 + wave, NGW = gridDim.x * 8;
#pragma unroll 2
    for (int m = gw; m < MTOK; m += NGW) {
        const f32x4* xr = (const f32x4*)(x + (size_t)m * DM) + lane;
        f32x4 v[4]; float s = 0.f;
#pragma unroll
        for (int jj = 0; jj < 4; ++jj) { v[jj] = xr[64 * jj]; s += (v[jj][0] * v[jj][0] + v[jj][1] * v[jj][1]) + (v[jj][2] * v[jj][2] + v[jj][3] * v[jj][3]); }
#pragma unroll
        for (int o = 1; o < 64; o <<= 1) s += __shfl_xor(s, o);
        u32x2* o8 = (u32x2*)(xb + (size_t)m * DM) + lane;
#pragma unroll
        for (int jj = 0; jj < 4; ++jj) { u32x2 w; w.x = cvtpk(v[jj][0], v[jj][1]); w.y = cvtpk(v[jj][2], v[jj][3]); o8[64 * jj] = w; }
        if (lane == 0) rstd[m] = rsqrtf(s * (1.0f / 1024.0f) + EPSN);
    }
}

__device__ __forceinline__ void rstd_pass(const float* ssq, float* rstd) {
    const int tid = opaque_tid();
    for (int row = blockIdx.x * 512 + tid; row < MTOK; row += gridDim.x * 512) {
        const f32x4* p = (const f32x4*)(ssq + (size_t)row * 16);
        const f32x4 a = p[0], b = p[1], c = p[2], d = p[3];
        const float s = ((a[0] + a[1]) + (a[2] + a[3])) + ((b[0] + b[1]) + (b[2] + b[3])) + ((c[0] + c[1]) + (c[2] + c[3])) + ((d[0] + d[1]) + (d[2] + d[3]));
        rstd[row] = rsqrtf(s * (1.0f / 1024.0f) + EPSN);
    }
}
constexpr int R_Q = 0, R_K = 34816, R_V = 71680, R_P = 92160, R_O = 101376;
__device__ __forceinline__ float bf2f(short x) { return __uint_as_float(((unsigned)(unsigned short)x) << 16); }
__device__ __forceinline__ void ret_phase(LAS unsigned char* L, const bf16_t* Qp, const bf16_t* Kp, bf16_t* Vp, const bf16_t* Gp, float* ssqp) {
    const int tid0 = opaque_tid(), w = __builtin_amdgcn_readfirstlane(tid0 >> 6);
#define RET_LANES() int tid = tid0; asm volatile("" : "+v"(tid)); const int lane = tid & 63, l15 = lane & 15, quad = lane >> 4, tq = l15 >> 2, tp = l15 & 3; (void)tq; (void)tp; (void)quad; (void)l15
    for (int uidx = blockIdx.x; uidx < 256; uidx += gridDim.x) {
        const int vcu = (uidx & 7) * 32 + (uidx >> 3);
        const int bh = vcu >> 2, vs = vcu & 3, b = bh >> 2, h = bh & 3;
        const float lg = __builtin_amdgcn_logf(1.0f - __builtin_amdgcn_exp2f(-5.0f - (float)h));
        const float ginv = __builtin_amdgcn_exp2f(-lg);
        f32x4 S[16];
#pragma unroll
        for (int k = 0; k < 16; ++k) S[k] = (f32x4){0.f, 0.f, 0.f, 0.f};
        const float cdec = __builtin_amdgcn_exp2f(lg * 64.0f);
        const size_t rowb = (size_t)b * SEQ;
        const int tid = tid0;
        const bf16_t* qsrc = Qp + (rowb + (tid >> 5)) * 1024 + h * 256 + (tid & 31) * 8;
        const bf16_t* ksrc = Kp + (rowb + (tid >> 5)) * 1024 + h * 256 + (tid & 31) * 8;
        bf16_t* vsrc = Vp + (rowb + (tid >> 4)) * 2048 + h * 512 + vs * 128 + (tid & 15) * 8;
        const bf16_t* gsrc = Gp + (rowb + (tid >> 4)) * 2048 + h * 512 + vs * 128 + (tid & 15) * 8;
        u32x4 rq[4], rk[4], rv[2], rg[2];
#pragma unroll
        for (int i = 0; i < 4; ++i) { rq[i] = *(const u32x4*)(qsrc + (size_t)i * 16 * 1024); rk[i] = *(const u32x4*)(ksrc + (size_t)i * 16 * 1024); }
#pragma unroll
        for (int i = 0; i < 2; ++i) rv[i] = *(const u32x4*)(vsrc + (size_t)i * 32 * 2048);
#pragma unroll 1
        for (int n = 0; n < 32; ++n) {
            const size_t row0 = rowb + n * 64;
            { RET_LANES();
#pragma unroll
            for (int i = 0; i < 4; ++i) { *(LAS u32x4*)(L + R_Q + ((tid >> 5) + 16 * i) * 544 + (tid & 31) * 16) = rq[i]; *(LAS u32x4*)(L + R_K + ((tid >> 5) + 16 * i) * 576 + (tid & 31) * 16) = rk[i]; }
#pragma unroll
            for (int i = 0; i < 2; ++i) *(LAS u32x4*)(L + R_V + ((tid >> 4) + 32 * i) * 320 + (tid & 15) * 16) = rv[i];
            }
            __syncthreads();
            if (n < 31) {
                const size_t adv = (size_t)(n + 1) * 64;
#pragma unroll
                for (int i = 0; i < 4; ++i) { rq[i] = *(const u32x4*)(qsrc + (adv + 16 * i) * 1024); rk[i] = *(const u32x4*)(ksrc + (adv + 16 * i) * 1024); }
#pragma unroll
                for (int i = 0; i < 2; ++i) rv[i] = *(const u32x4*)(vsrc + (adv + 32 * i) * 2048);
            }
            __builtin_amdgcn_sched_barrier(0);
            {
                RET_LANES();
                const int cb = w >> 1, eb0 = (w & 1) * 2;
                f32x4 sc0 = (f32x4){0.f, 0.f, 0.f, 0.f}, sc1 = sc0;
#pragma unroll
                for (int ks = 0; ks < 8; ++ks) {
                    const bf16x8 a = *(const LAS bf16x8*)(L + R_Q + (16 * cb + l15) * 544 + (32 * ks + 8 * quad) * 2);
                    const bf16x8 b0 = *(const LAS bf16x8*)(L + R_K + (16 * eb0 + l15) * 576 + (32 * ks + 8 * quad) * 2);
                    const bf16x8 b1 = *(const LAS bf16x8*)(L + R_K + (16 * (eb0 + 1) + l15) * 576 + (32 * ks + 8 * quad) * 2);
                    sc0 = MFMA16(b0, a, sc0); sc1 = MFMA16(b1, a, sc1);
                }
                const int c = 16 * cb + l15;
                float p0[4], p1[4];
#pragma unroll
                for (int i = 0; i < 4; ++i) { const int e0 = 16 * eb0 + 4 * quad + i, e1 = e0 + 16;
                    const float d0 = (float)(c > e0 ? c - e0 : e0 - c), d1 = (float)(c > e1 ? c - e1 : e1 - c);
                    p0[i] = sc0[i] * __builtin_amdgcn_exp2f(lg * d0); p1[i] = sc1[i] * __builtin_amdgcn_exp2f(lg * d1); }
                u32x2 w0, w1; w0.x = cvtpk(p0[0], p0[1]); w0.y = cvtpk(p0[2], p0[3]); w1.x = cvtpk(p1[0], p1[1]); w1.y = cvtpk(p1[2], p1[3]);
                *(LAS u32x2*)(L + R_P + c * 144 + (16 * eb0 + 4 * quad) * 2) = w0;
                *(LAS u32x2*)(L + R_P + c * 144 + (16 * (eb0 + 1) + 4 * quad) * 2) = w1;
            }
            __builtin_amdgcn_sched_barrier(0);
#pragma unroll
            for (int i = 0; i < 2; ++i) rg[i] = *(const u32x4*)(gsrc + ((size_t)n * 64 + 32 * i) * 2048);
            f32x4 oa[4]; bf16x8 bvs[2];
            { RET_LANES();
#pragma unroll
            for (int cb = 0; cb < 4; ++cb) oa[cb] = (f32x4){0.f, 0.f, 0.f, 0.f};
            {
                const LAS unsigned char* qb = L + R_Q + l15 * 544 + (8 * quad) * 2;
                bf16x8 qa[2][4];
#pragma unroll
                for (int cb = 0; cb < 4; ++cb) qa[0][cb] = *(const LAS bf16x8*)(qb + cb * 16 * 544);
#pragma unroll
                for (int ks = 0; ks < 8; ++ks) {
                    const int cu = ks & 1, nx = cu ^ 1;
                    if (ks < 7) {
#pragma unroll
                        for (int cb = 0; cb < 4; ++cb) qa[nx][cb] = *(const LAS bf16x8*)(qb + cb * 16 * 544 + (ks + 1) * 64);
                    }
                    __builtin_amdgcn_sched_barrier(0);
                    u32x4 bp; bp.x = cvtpk(S[2 * ks][0], S[2 * ks][1]); bp.y = cvtpk(S[2 * ks][2], S[2 * ks][3]); bp.z = cvtpk(S[2 * ks + 1][0], S[2 * ks + 1][1]); bp.w = cvtpk(S[2 * ks + 1][2], S[2 * ks + 1][3]);
                    const bf16x8 bst = __builtin_bit_cast(bf16x8, bp);
#pragma unroll
                    for (int cb = 0; cb < 4; ++cb) oa[cb] = MFMA16(bst, qa[cu][cb], oa[cb]);
                    __builtin_amdgcn_sched_barrier(0);
                }
            }
#pragma unroll
            for (int cb = 0; cb < 4; ++cb) oa[cb] = oa[cb] * __builtin_amdgcn_exp2f(lg * (float)(16 * cb + l15 + 1));
            }
            __builtin_amdgcn_sched_barrier(0);
            bf16x8 bvf[2];
            { RET_LANES();
#pragma unroll
            for (int ks = 0; ks < 2; ++ks) {
                const s16x4 vlo = trrd(L + R_V + (32 * ks + 8 * quad + tq) * 320 + (16 * w + 4 * tp) * 2);
                const s16x4 vhi = trrd(L + R_V + (32 * ks + 8 * quad + 4 + tq) * 320 + (16 * w + 4 * tp) * 2);
                bvf[ks] = cat8(vlo, vhi);
                float dj = __builtin_amdgcn_exp2f(lg * (float)(63 - 32 * ks - 8 * quad));
                float f[8] = {bf2f(vlo[0]), bf2f(vlo[1]), bf2f(vlo[2]), bf2f(vlo[3]), bf2f(vhi[0]), bf2f(vhi[1]), bf2f(vhi[2]), bf2f(vhi[3])};
#pragma unroll
                for (int q = 0; q < 8; ++q) { f[q] *= dj; dj *= ginv; }
                u32x4 sv; sv.x = cvtpk(f[0], f[1]); sv.y = cvtpk(f[2], f[3]); sv.z = cvtpk(f[4], f[5]); sv.w = cvtpk(f[6], f[7]);
                bvs[ks] = __builtin_bit_cast(bf16x8, sv);
            }
            }
            __builtin_amdgcn_sched_barrier(0);
            __builtin_amdgcn_sched_barrier(0);
            { RET_LANES();
#pragma unroll
            for (int k = 0; k < 16; ++k) S[k] = S[k] * cdec;
            {
                const LAS unsigned char* kb = L + R_K + (8 * quad + tq) * 576 + (8 * tp) * 2;
                s16x4 klo[2][4], khi[2][4];
#pragma unroll
                for (int kk = 0; kk < 4; ++kk) { klo[0][kk] = trrd((LAS unsigned char*)kb + (kk >> 1) * 64 + (kk & 1) * 8); khi[0][kk] = trrd((LAS unsigned char*)kb + 4 * 576 + (kk >> 1) * 64 + (kk & 1) * 8); }
#pragma unroll
                for (int g = 0; g < 8; ++g) {
                    const int cu = g & 1, nx = cu ^ 1;
                    if (g < 7) { const int ks1 = (g + 1) >> 2, k41 = (g + 1) & 3;
#pragma unroll
                        for (int kk = 0; kk < 4; ++kk) { klo[nx][kk] = trrd((LAS unsigned char*)kb + ks1 * 32 * 576 + ((4 * k41 + kk) >> 1) * 64 + (kk & 1) * 8); khi[nx][kk] = trrd((LAS unsigned char*)kb + ks1 * 32 * 576 + 4 * 576 + ((4 * k41 + kk) >> 1) * 64 + (kk & 1) * 8); }
                    }
                    __builtin_amdgcn_sched_barrier(0);
#pragma unroll
                    for (int kk = 0; kk < 4; ++kk) S[4 * (g & 3) + kk] = MFMA16(cat8(klo[cu][kk], khi[cu][kk]), bvs[g >> 2], S[4 * (g & 3) + kk]);
                    __builtin_amdgcn_sched_barrier(0);
                }
            }
            }
            __syncthreads();
            { RET_LANES();
#pragma unroll
            for (int ks = 0; ks < 2; ++ks) {
                bf16x8 pa[4];
#pragma unroll
                for (int cb = 0; cb < 4; ++cb) pa[cb] = *(const LAS bf16x8*)(L + R_P + (16 * cb + l15) * 144 + (32 * ks + 8 * quad) * 2);
#pragma unroll
                for (int cb = 0; cb < 4; ++cb) oa[cb] = MFMA16(bvf[ks], pa[cb], oa[cb]);
            }
#pragma unroll
            for (int cb = 0; cb < 4; ++cb) { u32x2 ow; ow.x = cvtpk(oa[cb][0], oa[cb][1]); ow.y = cvtpk(oa[cb][2], oa[cb][3]);
                *(LAS u32x2*)(L + R_O + (16 * cb + l15) * 272 + (16 * w + 4 * quad) * 2) = ow; }
            }
            __syncthreads();
            { RET_LANES();
#pragma unroll
            for (int i = 0; i < 2; ++i) {
                const int row = (tid >> 4) + 32 * i;
                const u32x4 o = *(const LAS u32x4*)(L + R_O + row * 272 + (tid & 15) * 16);
                const u32x4 g = rg[i];
                const float ov[8] = {bflo(o.x), bfhi(o.x), bflo(o.y), bfhi(o.y), bflo(o.z), bfhi(o.z), bflo(o.w), bfhi(o.w)};
                const float gv[8] = {bflo(g.x), bfhi(g.x), bflo(g.y), bfhi(g.y), bflo(g.z), bfhi(g.z), bflo(g.w), bfhi(g.w)};
                float ss = 0.f; float y[8];
#pragma unroll
                for (int q = 0; q < 8; ++q) { ss += ov[q] * ov[q]; y[q] = ov[q] * gv[q]; }
                u32x4 yv; yv.x = cvtpk(y[0], y[1]); yv.y = cvtpk(y[2], y[3]); yv.z = cvtpk(y[4], y[5]); yv.w = cvtpk(y[6], y[7]);
                *(u32x4*)(vsrc + ((size_t)n * 64 + 32 * i) * 2048) = yv;
                ss += __shfl_xor(ss, 1); ss += __shfl_xor(ss, 2); ss += __shfl_xor(ss, 4); ss += __shfl_xor(ss, 8);
                if ((tid & 15) == 0) ssqp[(row0 + row) * 16 + h * 4 + vs] = ss;
            }
            }
        }
        __syncthreads();
    }
}
#undef RET_LANES
constexpr int SB_KP = 144, SB_VP = 192, SB_KS = 64 * SB_KP, SB_VS = 64 * SB_VP, SB_VOFF = 6 * SB_KS, SB_FLAG = SB_VOFF + 6 * SB_VS;
constexpr float SB_STOP = 1.0995116e12f;
__device__ __forceinline__ void sb_tile(LAS unsigned char* Kb, LAS unsigned char* Vb, const bf16x8 (&qf)[4], f32x16& o0, f32x16& o1, float& carry,
                                        int kt, int q0, int qabs, int pir, int hf, int g1, int tq, int tp) {
    f32x16 s0, s1;
#pragma unroll
    for (int i = 0; i < 16; ++i) { s0[i] = 0.f; s1[i] = 0.f; }
#pragma unroll
    for (int ks = 0; ks < 4; ++ks) {
        const bf16x8 a0 = *(const LAS bf16x8*)(Kb + pir * SB_KP + (16 * ks + 8 * hf) * 2);
        const bf16x8 a1 = *(const LAS bf16x8*)(Kb + (pir + 16) * SB_KP + (16 * ks + 8 * hf) * 2);
        s0 = MFMA32(a0, qf[ks], s0); s1 = MFMA32(a1, qf[ks], s1);
    }
    const int kbase = 64 * kt + 32 * hf;
    if (64 * kt + 63 >= q0) {
#pragma unroll
        for (int i = 0; i < 16; ++i) { if (!(kbase + i < qabs)) s0[i] = -1e30f; if (!(kbase + 16 + i < qabs)) s1[i] = -1e30f; }
    }
    float dl = 1.0f;
#pragma unroll
    for (int i = 15; i >= 0; --i) { const float e = __builtin_amdgcn_exp2f(s1[i]); dl *= (1.0f + e); s1[i] = e * __builtin_amdgcn_rcpf(dl); }
#pragma unroll
    for (int i = 15; i >= 0; --i) { const float e = __builtin_amdgcn_exp2f(s0[i]); dl *= (1.0f + e); s0[i] = e * __builtin_amdgcn_rcpf(dl); }
    const float pdl = __shfl_xor(dl, 32);
    const float fac = __builtin_amdgcn_rcpf(carry * (hf == 0 ? pdl : 1.0f));
    carry = carry * dl * pdl;
#pragma unroll
    for (int mb = 0; mb < 2; ++mb)
#pragma unroll
        for (int s = 0; s < 2; ++s) {
            u32x4 pw;
            if (mb == 0) { pw.x = cvtpk(s0[8 * s + 0] * fac, s0[8 * s + 1] * fac); pw.y = cvtpk(s0[8 * s + 2] * fac, s0[8 * s + 3] * fac); pw.z = cvtpk(s0[8 * s + 4] * fac, s0[8 * s + 5] * fac); pw.w = cvtpk(s0[8 * s + 6] * fac, s0[8 * s + 7] * fac); }
            else         { pw.x = cvtpk(s1[8 * s + 0] * fac, s1[8 * s + 1] * fac); pw.y = cvtpk(s1[8 * s + 2] * fac, s1[8 * s + 3] * fac); pw.z = cvtpk(s1[8 * s + 4] * fac, s1[8 * s + 5] * fac); pw.w = cvtpk(s1[8 * s + 6] * fac, s1[8 * s + 7] * fac); }
            const bf16x8 pk = __builtin_bit_cast(bf16x8, pw);
            const int krow = 32 * hf + 16 * mb + 8 * s + tq;
            { const s16x4 vlo = trrd(Vb + krow * SB_VP + (16 * g1 + 4 * tp) * 2), vhi = trrd(Vb + (krow + 4) * SB_VP + (16 * g1 + 4 * tp) * 2);
              o0 = MFMA32(cat8(vlo, vhi), pk, o0); }
            { const s16x4 vlo = trrd(Vb + krow * SB_VP + (32 + 16 * g1 + 4 * tp) * 2), vhi = trrd(Vb + (krow + 4) * SB_VP + (32 + 16 * g1 + 4 * tp) * 2);
              o1 = MFMA32(cat8(vlo, vhi), pk, o1); }
        }
}
__device__ __forceinline__ void sb_phase(LAS unsigned char* L, const bf16_t* Qp, const bf16_t* Kp, const bf16_t* Vp, bf16_t* Op) {
    const int tid = opaque_tid(), lane = tid & 63, w = __builtin_amdgcn_readfirstlane(tid >> 6), n = lane & 31, hf = lane >> 5, g1 = (lane >> 4) & 1, tq = (lane & 15) >> 2, tp = lane & 3;
    const int pir = 32 * ((n >> 2) & 1) + (n & 3) + 4 * (n >> 3);
    const int sr = tid >> 3, sch = tid & 7;
    LAS unsigned* flags = (LAS unsigned*)(L + SB_FLAG);
    for (int bh = blockIdx.x; bh < 256; bh += gridDim.x) {
        const int b = bh >> 4, h = bh & 15;
        const size_t tb = (size_t)b * SEQ;
        const bf16_t* kcol = Kp + (tb + sr) * 1024 + h * 64 + sch * 8;
        const bf16_t* vcol = Vp + (tb + sr) * 1024 + h * 64 + sch * 8;
        u32x4 kreg[6], vreg[6]; bf16x8 qn[4];
#pragma unroll
        for (int ks = 0; ks < 4; ++ks) qn[ks] = *(const bf16x8*)(Qp + (tb + 256 * 7 + 32 * w + n) * 1024 + h * 64 + 16 * ks + 8 * hf);
        { const int lo = 4 * 7 - 2;
#pragma unroll
          for (int j = 0; j < 6; ++j) { kreg[j] = *(const u32x4*)(kcol + (size_t)(lo + j) * 64 * 1024); vreg[j] = *(const u32x4*)(vcol + (size_t)(lo + j) * 64 * 1024); } }
#pragma unroll 1
        for (int kq = 7; kq >= 0; --kq) {
            int lo = 4 * kq - 2; if (lo < 0) lo = 0;
            const int q0 = 256 * kq + 32 * w, qabs = q0 + n;
            bf16x8 qf[4];
#pragma unroll
            for (int ks = 0; ks < 4; ++ks) qf[ks] = qn[ks];
#pragma unroll
            for (int j = 0; j < 6; ++j) { *(LAS u32x4*)(L + j * SB_KS + sr * SB_KP + sch * 16) = kreg[j]; *(LAS u32x4*)(L + SB_VOFF + j * SB_VS + sr * SB_VP + sch * 16) = vreg[j]; }
            __syncthreads();
            if (kq > 0) { int nlo = 4 * (kq - 1) - 2; if (nlo < 0) nlo = 0; const int ncnt = 4 * (kq - 1) + 4 - nlo;
#pragma unroll
                for (int ks = 0; ks < 4; ++ks) qn[ks] = *(const bf16x8*)(Qp + (tb + 256 * (kq - 1) + 32 * w + n) * 1024 + h * 64 + 16 * ks + 8 * hf);
#pragma unroll
                for (int j = 0; j < 6; ++j) if (j < ncnt) { kreg[j] = *(const u32x4*)(kcol + (size_t)(nlo + j) * 64 * 1024); vreg[j] = *(const u32x4*)(vcol + (size_t)(nlo + j) * 64 * 1024); } }
            f32x16 o0, o1;
#pragma unroll
            for (int i = 0; i < 16; ++i) { o0[i] = 0.f; o1[i] = 0.f; }
            float carry = 1.0f;
            int kt = (q0 + 30) >> 6; bool done = false;
#pragma unroll 1
            for (; kt >= lo; --kt) {
                sb_tile(L + (kt - lo) * SB_KS, L + SB_VOFF + (kt - lo) * SB_VS, qf, o0, o1, carry, kt, q0, qabs, pir, hf, g1, tq, tp);
                if (__all(carry >= SB_STOP)) { done = true; break; }
            }
            bool need = !done && lo > 0;
            if (lane == 0) flags[w] = need ? 1u : 0u;
            __syncthreads();
            int flo = lo;
#pragma unroll 1
            for (;;) {
                unsigned any = 0;
#pragma unroll
                for (int q = 0; q < 8; ++q) any |= flags[q];
                if (!any) break;
                --flo;
                const u32x4 kx = *(const u32x4*)(kcol + (size_t)flo * 64 * 1024), vx = *(const u32x4*)(vcol + (size_t)flo * 64 * 1024);
                __syncthreads();
                *(LAS u32x4*)(L + sr * SB_KP + sch * 16) = kx; *(LAS u32x4*)(L + SB_VOFF + sr * SB_VP + sch * 16) = vx;
                __syncthreads();
                if (need) {
                    sb_tile(L, L + SB_VOFF, qf, o0, o1, carry, flo, q0, qabs, pir, hf, g1, tq, tp);
                    if (__all(carry >= SB_STOP) || flo == 0) need = false;
                }
                if (lane == 0) flags[w] = need ? 1u : 0u;
                __syncthreads();
            }
            bf16_t* orow = Op + (tb + qabs) * 1024 + h * 64;
#pragma unroll
            for (int g4 = 0; g4 < 4; ++g4) {
                u32x2 w0, w1; w0.x = cvtpk(o0[4 * g4], o0[4 * g4 + 1]); w0.y = cvtpk(o0[4 * g4 + 2], o0[4 * g4 + 3]); w1.x = cvtpk(o1[4 * g4], o1[4 * g4 + 1]); w1.y = cvtpk(o1[4 * g4 + 2], o1[4 * g4 + 3]);
                *(u32x2*)(orow + 8 * g4 + 4 * hf) = w0; *(u32x2*)(orow + 32 + 8 * g4 + 4 * hf) = w1;
            }
        }
        __syncthreads();
    }
}

__global__ void __launch_bounds__(512, 2) fwd_kernel(Args a) {
    extern __shared__ __attribute__((aligned(16))) unsigned char lds[];
    LAS unsigned char* L = (LAS unsigned char*)lds;
    cg::grid_group grid = cg::this_grid();
    const int G = gridDim.x, bx = blockIdx.x;
    { unsigned char* ws0 = a.ws; x_pass(a.in[0], (bf16_t*)(ws0 + WS_XB), (float*)(ws0 + WS_RSTD)); }
    conv_weights(a, 0, L);
    unsigned* barw = (unsigned*)(a.ws + WS_BAR);
    volatile LAS unsigned* bst = (volatile LAS unsigned*)(L + LDS_BYTES - 64);
    if (bx == 0) { for (int u = threadIdx.x; u < XCD_BAR_WORDS; u += 512) barw[u] = 0u; }
    if (threadIdx.x < 2) bst[threadIdx.x] = 0u;
    grid.sync();
    const XcdBarrier bar = xcd_barrier_post(barw, bst);
#define GSYNC() xcd_barrier(bar)
#pragma unroll 1
    for (int i = 0; i < 4; ++i) {
        const int j = i >> 1; const bool ret = !(i & 1);
        if (i > 0) { conv_weights(a, i, L); rstd_pass((const float*)(a.ws + WS_SSQ), (float*)(a.ws + WS_RSTD)); GSYNC(); }
        size_t zoff = 0; asm volatile("" : "+s"(zoff)); unsigned char* ws = a.ws + zoff;
        float* ssq = (float*)(ws + WS_SSQ); float* ssqp = (float*)(ws + WS_SSQP); float* rstd = (float*)(ws + WS_RSTD);
        bf16_t* wb = (bf16_t*)(ws + WS_W); bf16_t* xb = (bf16_t*)(ws + WS_XB); bf16_t* act = (bf16_t*)(ws + WS_ACT);
        bf16_t* W_mi = wb + W_MI / 2; bf16_t* W_mo = wb + W_MO / 2; bf16_t* W_fi = wb + W_FI / 2; bf16_t* W_fo = wb + W_FO / 2;
        const bf16_t* moA; int moK;
        if (ret) {
            { pg8::Gemm g{xb, W_mi, MTOK, 6144, 1024}; pg8::StaticOrder S; S.init(MTOK, 6144, G, bx);
              pg8::EpiRetProj E{act, rstd};
              pg8::gemm_phase<pg8::EpiRetProj, pg8::StaticOrder, true, true>(L, g, S, E); }
            GSYNC();
            ret_phase(L, act, act + (size_t)MTOK * 1024, act + (size_t)MTOK * 2048, act + (size_t)MTOK * 4096, ssqp);
            GSYNC();
            moA = act + (size_t)MTOK * 2048; moK = 2048;
        } else {
            { pg8::Gemm g{xb, W_mi, MTOK, 3072, 1024}; pg8::StaticOrder S; S.init(MTOK, 3072, G, bx);
              pg8::EpiSbProj E{act, rstd, a.in[7] + j * 64, a.in[8] + j * 64};
              pg8::gemm_phase<pg8::EpiSbProj, pg8::StaticOrder, true, true>(L, g, S, E); }
            GSYNC();
            sb_phase(L, act, act + (size_t)MTOK * 1024, act + (size_t)MTOK * 2048, act + (size_t)MTOK * 3072);
            GSYNC();
            moA = act + (size_t)MTOK * 3072; moK = 1024;
        }
        { pg8::Gemm g{moA, W_mo, MTOK, 1024, moK}; pg8::StaticOrder S; S.init(MTOK, 1024, G, bx);
          pg8::EpiResid E{nullptr, xb, ssq, ret ? ssqp : nullptr};
          pg8::gemm_phase<pg8::EpiResid, pg8::StaticOrder, true, true>(L, g, S, E); }
        GSYNC();
        rstd_pass(ssq, rstd);
        GSYNC();
        { pg8::Gemm g{xb, W_fi, MTOK, 2 * FFH, 1024}; pg8::StaticOrder S; S.init(MTOK, 2 * FFH, G, bx);
          pg8::EpiFfnIn E{act, rstd};
          pg8::gemm_phase<pg8::EpiFfnIn, pg8::StaticOrder, true, true>(L, g, S, E); }
        GSYNC();
        { pg8::Gemm g{act, W_fo, MTOK, 1024, FFH}; pg8::StaticOrder S; S.init(MTOK, 1024, G, bx);
          pg8::EpiResid E{(i < 3) ? nullptr : a.out, xb, ssq, nullptr};
          pg8::gemm_phase<pg8::EpiResid, pg8::StaticOrder, true, true>(L, g, S, E); }
        if (i < 3) GSYNC();
    }
}

extern "C" void kernel_launch(void* const* d_in, const int* in_sizes, int n_in, void* d_out, int out_size, void* d_ws, size_t ws_size, hipStream_t stream) {
    static int grid_blocks = 0;
    if (grid_blocks == 0) {
        if (n_in != 12 || out_size != MTOK * DM || ws_size < WS_END) { fprintf(stderr, "kernel_launch: unexpected shapes (n_in %d out %d ws %zu)\n", n_in, out_size, ws_size); grid_blocks = -1; return; }
        int dev = 0, cus = 0, per_cu = 0;
        (void)hipGetDevice(&dev);
        (void)hipDeviceGetAttribute(&cus, hipDeviceAttributeMultiprocessorCount, dev);
        (void)hipFuncSetAttribute((const void*)fwd_kernel, hipFuncAttributeMaxDynamicSharedMemorySize, LDS_BYTES);
        (void)hipOccupancyMaxActiveBlocksPerMultiprocessor(&per_cu, (const void*)fwd_kernel, 512, LDS_BYTES);
        if (per_cu < 1) per_cu = 1;
        grid_blocks = cus * per_cu;
    }
    if (grid_blocks < 0) return;
    Args a{};
    for (int i = 0; i < 12; ++i) a.in[i] = (const float*)d_in[i];
    a.out = (float*)d_out; a.ws = (unsigned char*)d_ws;
    void* args[] = {&a};
    hipError_t e = hipLaunchCooperativeKernel((const void*)fwd_kernel, dim3(grid_blocks), dim3(512), args, LDS_BYTES, stream);
    if (e != hipSuccess) fprintf(stderr, "cooperative launch failed: %s (grid %d)\n", hipGetErrorString(e), grid_blocks);
}
```

```cpp
#include <hip/hip_runtime.h>
#include <hip/hip_cooperative_groups.h>
#include <cstdio>
#include <cstdint>
namespace cg = cooperative_groups;
constexpr int MTOK = 32768, DM = 1024, SEQ = 2048, FFH = 2816;
constexpr float EPSN = 1e-6f;
constexpr float C2SB = 0.125f * 1.4426950408889634f;
__device__ __forceinline__ int opaque_tid() { int t = threadIdx.x; asm volatile("" : "+v"(t)); return t; }
namespace pg8 {
#define PG8_LAS __attribute__((address_space(3)))
typedef unsigned short bf16_t;
typedef short bf16x8 __attribute__((ext_vector_type(8)));
typedef float f32x4 __attribute__((ext_vector_type(4)));
typedef unsigned u32x4 __attribute__((ext_vector_type(4)));
constexpr int BM = 256, BK = 64, HALF = 128, HTB = HALF * BK * 2  , STAGE_BYTES = 8 * HTB, NXCD = 8, WGM = 8;

__host__ __device__ __forceinline__ int lds_byte(int r, int c) { const int st = (r >> 4) * 2 + (c >> 5), rr = r & 15, cc = c & 31, ob = rr * 64 + cc * 2; return st * 1024 + (ob ^ (((ob >> 9) & 1) << 5)); }
__host__ __device__ __forceinline__ void stage_rc(int b, int& R, int& C) { const int st = b / 1024, sb = b % 1024, swz = sb ^ (((sb >> 9) & 1) << 5); R = (st >> 1) * 16 + swz / 64; C = (st & 1) * 32 + (swz % 64) / 2; }
__host__ __device__ __forceinline__ int perm32(int rho) { const int n = rho >> 4, i = rho & 15; return 8 * (i >> 2) + 4 * n + (i & 3); }

struct Unit { int pm, pn; };
struct Gemm { const bf16_t* A; const bf16_t* Bt; int M, N, K; };

struct StaticOrder {
    int nM, nN, nwg, G, c;
    __host__ __device__ void init(int M, int N, int G_, int c_) { nM = M / BM; nN = N / BM; nwg = nM * nN; G = G_; c = c_; }
    __host__ __device__ bool next(int i, Unit& u) const {
        const long L = (long)i * G + c; if (L >= nwg) return false;
        int wgid = (int)L; { const int q = nwg / NXCD, r = nwg % NXCD, xcd = wgid % NXCD, off = wgid / NXCD; wgid = (xcd < r ? xcd * (q + 1) : r * (q + 1) + (xcd - r) * q) + off; }
        const int nig = WGM * nN, gid = wgid / nig, fm = gid * WGM, gsz = (nM - fm) < WGM ? (nM - fm) : WGM;
        u.pm = fm + ((wgid % nig) % gsz); u.pn = (wgid % nig) / gsz; return true;
    }
    __device__ __forceinline__ void a_ready(const Unit&) const {}
    __device__ __forceinline__ void done(const Unit&) const {}
};

__device__ __forceinline__ unsigned cvt_pk_bf16(float lo, float hi) { unsigned r; asm volatile("v_cvt_pk_bf16_f32 %0, %1, %2" : "=v"(r) : "v"(lo), "v"(hi)); return r; }
template <class Epi, class Sched, bool ALIGN_EPI = false, bool SP2 = false>
__device__ __forceinline__ void gemm_phase(PG8_LAS unsigned char* lds, const Gemm g, const Sched& S, const Epi& E) {
    const int tid = opaque_tid(), wid = __builtin_amdgcn_readfirstlane(tid >> 6), lane = tid & 63, wr = wid >> 2, wc = wid & 3, fr = lane & 15, fq = lane >> 4;
    const int K = g.K, nt = K / BK;
    unsigned voffA[2], voffB[2];
#pragma unroll
    for (int i = 0; i < 2; ++i) { int R, C; stage_rc(tid * 16 + i * 8192, R, C); const int Rb = Epi::PERM ? ((R & ~31) + perm32(R & 31)) : R;
        voffA[i] = (unsigned)(R * K + C) * 2u; voffB[i] = (unsigned)(Rb * K + C) * 2u; }
    const size_t kstep = (size_t)(BK * 2);
    const size_t hstep = (size_t)HALF * K * 2;
    const size_t tstep = 2 * hstep;
    const unsigned ldsw = (unsigned)wid * 1024u;
    const int aoff = lds_byte(wr * 64 + fr, fq * 8), boff = lds_byte(wc * 32 + fr, fq * 8);
#define PG8_SA(b, h) (((b) * 2 + (h)) * HTB)
#define PG8_SB(b, h) ((4 + (b) * 2 + (h)) * HTB)
#define PG8_STAGE(bufoff, gbase, voff) do { _Pragma("unroll") for (int _i = 0; _i < 2; ++_i) \
        __builtin_amdgcn_global_load_lds((const unsigned*)((const char*)(gbase) + (voff)[_i]), (PG8_LAS unsigned*)(lds + (bufoff) + ldsw + _i * 8192), 16, 0, 0); } while (0)
#define PG8_LDA(dst, b, h) do { _Pragma("unroll") for (int m = 0; m < 4; ++m) _Pragma("unroll") for (int k = 0; k < 2; ++k) dst[m][k] = *(const PG8_LAS bf16x8*)(lds + PG8_SA(b, h) + aoff + m * 2048 + k * 1024); } while (0)
#define PG8_LDB(dst, b, h) do { _Pragma("unroll") for (int n = 0; n < 2; ++n) _Pragma("unroll") for (int k = 0; k < 2; ++k) dst[n][k] = *(const PG8_LAS bf16x8*)(lds + PG8_SB(b, h) + boff + n * 2048 + k * 1024); } while (0)
#define PG8_MMA(ai, bj, At, Bt) do { __builtin_amdgcn_s_setprio(1); _Pragma("unroll") for (int m = 0; m < 4; ++m) _Pragma("unroll") for (int n = 0; n < 2; ++n) _Pragma("unroll") for (int k = 0; k < 2; ++k) \
        acc[ai][bj][m][n] = __builtin_amdgcn_mfma_f32_16x16x32_bf16(Bt[n][k], At[m][k], acc[ai][bj][m][n], 0, 0, 0); __builtin_amdgcn_s_setprio(0); } while (0)
#define PG8_WAIT_V(n) asm volatile("s_waitcnt vmcnt(" #n ")" ::: "memory")
#define PG8_WAIT_L(n) asm volatile("s_waitcnt lgkmcnt(" #n ")" ::: "memory")
#define PG8_BAR __builtin_amdgcn_s_barrier()
#define PG8_SCHED __builtin_amdgcn_sched_barrier(0)
    Unit cur, nxt; int ui = 0;
    float rowc[8]; int rowc_pm = -1;
#pragma unroll
    for (int q = 0; q < 8; ++q) rowc[q] = 0.f;
    if (!S.next(0, cur)) return;
    f32x4 acc[2][2][4][2];
#pragma unroll
    for (int a = 0; a < 2; ++a)
#pragma unroll
        for (int b = 0; b < 2; ++b)
#pragma unroll
            for (int m = 0; m < 4; ++m)
#pragma unroll
                for (int n = 0; n < 2; ++n) acc[a][b][m][n] = (f32x4){0.f, 0.f, 0.f, 0.f};
    bf16x8 At[4][2], B0[2][2], B1[2][2];
    const char* cA = (const char*)g.A + (size_t)cur.pm * tstep; const char* cB = (const char*)g.Bt + (size_t)cur.pn * tstep;
    S.a_ready(cur);
    if constexpr (SP2) {
        PG8_STAGE(PG8_SB(0, 0), cB, voffB); PG8_STAGE(PG8_SB(0, 1), cB + hstep, voffB); PG8_STAGE(PG8_SA(0, 0), cA, voffA); PG8_STAGE(PG8_SA(0, 1), cA + hstep, voffA);
        if (wr == 1) PG8_BAR;
        PG8_WAIT_V(2); PG8_BAR;
        PG8_STAGE(PG8_SB(1, 0), cB + kstep, voffB); PG8_STAGE(PG8_SA(1, 0), cA + kstep, voffA); PG8_STAGE(PG8_SB(1, 1), cB + hstep + kstep, voffB);
        PG8_WAIT_V(6); PG8_BAR;
    } else {
        PG8_STAGE(PG8_SB(0, 0), cB, voffB); PG8_STAGE(PG8_SA(0, 0), cA, voffA); PG8_STAGE(PG8_SB(0, 1), cB + hstep, voffB); PG8_STAGE(PG8_SA(0, 1), cA + hstep, voffA);
        if (wr == 1) PG8_BAR;
        PG8_WAIT_V(4); PG8_BAR;
        PG8_STAGE(PG8_SB(1, 0), cB + kstep, voffB); PG8_STAGE(PG8_SA(1, 0), cA + kstep, voffA); PG8_STAGE(PG8_SB(1, 1), cB + hstep + kstep, voffB);
        PG8_WAIT_V(6); PG8_BAR;
    }
    for (;;) {
        const bool has_next = S.next(ui + 1, nxt);
        const char* nA = has_next ? (const char*)g.A + (size_t)nxt.pm * tstep : cA; const char* nB = has_next ? (const char*)g.Bt + (size_t)nxt.pn * tstep : cB;
        for (int t = 0; t < nt; t += 2) {
            const bool last = (t == nt - 2);
            const char* a1 = cA + (size_t)(t + 1) * kstep;
            const char* a2 = last ? nA : cA + (size_t)(t + 2) * kstep; const char* b2 = last ? nB : cB + (size_t)(t + 2) * kstep;
            const char* a3 = a2 + kstep; const char* b3 = b2 + kstep;
            if (last && has_next) S.a_ready(nxt);
            if constexpr (SP2) {
            PG8_LDB(B0, 0, 0); PG8_LDB(B1, 0, 1); PG8_SCHED; PG8_LDA(At, 0, 0); PG8_STAGE(PG8_SA(1, 1), a1 + hstep, voffA);
            PG8_WAIT_V(8); PG8_WAIT_L(0); PG8_BAR; PG8_MMA(0, 0, At, B0); PG8_MMA(0, 1, At, B1); PG8_BAR; PG8_SCHED;
            PG8_LDA(At, 0, 1); PG8_STAGE(PG8_SB(0, 0), b2, voffB); PG8_STAGE(PG8_SB(0, 1), b2 + hstep, voffB); PG8_STAGE(PG8_SA(0, 0), a2, voffA);
            PG8_WAIT_V(8); PG8_WAIT_L(0); PG8_BAR; PG8_MMA(1, 0, At, B0); PG8_MMA(1, 1, At, B1); PG8_BAR; PG8_SCHED;
            PG8_LDB(B0, 1, 0); PG8_LDB(B1, 1, 1); PG8_SCHED; PG8_LDA(At, 1, 0); PG8_STAGE(PG8_SA(0, 1), a2 + hstep, voffA);
            PG8_WAIT_V(8); PG8_WAIT_L(0); PG8_BAR; PG8_MMA(0, 0, At, B0); PG8_MMA(0, 1, At, B1); PG8_BAR; PG8_SCHED;
            PG8_LDA(At, 1, 1); PG8_STAGE(PG8_SB(1, 0), b3, voffB); PG8_STAGE(PG8_SB(1, 1), b3 + hstep, voffB); PG8_STAGE(PG8_SA(1, 0), a3, voffA);
            PG8_WAIT_V(8); PG8_WAIT_L(0); PG8_BAR; PG8_MMA(1, 0, At, B0); PG8_MMA(1, 1, At, B1); PG8_BAR; PG8_SCHED;
            } else {
            PG8_LDB(B0, 0, 0); PG8_SCHED; PG8_LDA(At, 0, 0); PG8_STAGE(PG8_SA(1, 1), a1 + hstep, voffA);
            PG8_WAIT_L(8); PG8_BAR; PG8_WAIT_L(0); PG8_MMA(0, 0, At, B0); PG8_BAR; PG8_SCHED;
            PG8_LDB(B1, 0, 1); PG8_STAGE(PG8_SB(0, 0), b2, voffB);
            PG8_BAR; PG8_WAIT_L(0); PG8_MMA(0, 1, At, B1); PG8_BAR;
            PG8_LDA(At, 0, 1); PG8_STAGE(PG8_SA(0, 0), a2, voffA);
            PG8_BAR; PG8_WAIT_L(0); PG8_MMA(1, 0, At, B0); PG8_BAR; PG8_SCHED;
            PG8_STAGE(PG8_SB(0, 1), b2 + hstep, voffB);
            PG8_WAIT_V(6); PG8_BAR; PG8_MMA(1, 1, At, B1); PG8_BAR;
            PG8_LDB(B0, 1, 0); PG8_SCHED; PG8_LDA(At, 1, 0); PG8_STAGE(PG8_SA(0, 1), a2 + hstep, voffA);
            PG8_WAIT_L(8); PG8_BAR; PG8_WAIT_L(0); PG8_MMA(0, 0, At, B0); PG8_BAR; PG8_SCHED;
            PG8_LDB(B1, 1, 1); PG8_STAGE(PG8_SB(1, 0), b3, voffB);
            PG8_BAR; PG8_WAIT_L(0); PG8_MMA(0, 1, At, B1); PG8_BAR;
            PG8_LDA(At, 1, 1); PG8_STAGE(PG8_SA(1, 0), a3, voffA);
            PG8_BAR; PG8_WAIT_L(0); PG8_MMA(1, 0, At, B0); PG8_BAR; PG8_SCHED;
            PG8_STAGE(PG8_SB(1, 1), b3 + hstep, voffB);
            PG8_WAIT_V(6); PG8_BAR; PG8_MMA(1, 1, At, B1); PG8_BAR;
            }
            if constexpr (Epi::HEAD_HOOK) { if (E.hook_on() && ((t + 2) & 7) == 0 && !last) { E.rescale(acc, cur, wr, fr, (t + 2) >> 3); PG8_SCHED; } }
        }
        if constexpr (ALIGN_EPI) { if (wr == 0) PG8_BAR; }
        if constexpr (!Epi::AFTER_DRAIN) { E(acc, cur, wr, wc, fr, fq, rowc, rowc_pm); S.done(cur); }
        if (!has_next) break;
#pragma unroll
        for (int a = 0; a < 2; ++a)
#pragma unroll
            for (int b = 0; b < 2; ++b)
#pragma unroll
                for (int m = 0; m < 4; ++m)
#pragma unroll
                    for (int n = 0; n < 2; ++n) acc[a][b][m][n] = (f32x4){0.f, 0.f, 0.f, 0.f};
        cur = nxt; cA = nA; cB = nB; ++ui;
        if constexpr (ALIGN_EPI) { if (wr == 1) PG8_BAR; }
    }
    PG8_WAIT_V(0);
    if constexpr (!ALIGN_EPI) { if (wr == 0) PG8_BAR; }
    PG8_BAR;
    if constexpr (Epi::AFTER_DRAIN) { E.fused(acc, cur, wr, wc, fr, fq, lds, wid, lane); S.done(cur); }
#undef PG8_SA
#undef PG8_SB
#undef PG8_STAGE
#undef PG8_LDA
#undef PG8_LDB
#undef PG8_MMA
#undef PG8_WAIT_V
#undef PG8_WAIT_L
#undef PG8_BAR
#undef PG8_SCHED
}
typedef float f32x2_t __attribute__((ext_vector_type(2))); typedef __bf16 bf16x2_t __attribute__((ext_vector_type(2)));
__device__ __forceinline__ unsigned cvtpk(float lo, float hi) { f32x2_t v = {lo, hi}; bf16x2_t b = __builtin_convertvector(v, bf16x2_t); return __builtin_bit_cast(unsigned, b); }
__device__ __forceinline__ float bflo(unsigned u) { return __uint_as_float(u << 16); }
__device__ __forceinline__ float bfhi(unsigned u) { return __uint_as_float(u & 0xffff0000u); }
__device__ __forceinline__ float row_rstd(const float* rstd, int row) { return rstd[row]; }
__device__ __forceinline__ void row_rstd8(const float* rstd, int row0, float (&rs)[8]) {
#pragma unroll
    for (int q = 0; q < 8; ++q) rs[q] = rstd[row0 + (q >> 2) * HALF + (q & 3) * 16];
}

struct EpiRetProj {
    static constexpr bool PERM = true, AFTER_DRAIN = false, HEAD_HOOK = false;
    bf16_t* act; const float* ssq;
    __device__ __forceinline__ void operator()(const f32x4 (&acc)[2][2][4][2], const Unit& u, int wr, int wc, int fr_, int fq_, float (&rs8)[8], int& rs_pm) const {
        int fr = fr_, fq = fq_; asm volatile("" : "+v"(fr), "+v"(fq));
        const int row0 = u.pm * BM + wr * 64 + fr; const int pn = u.pn;
        if (u.pm != rs_pm) { row_rstd8(ssq, row0, rs8); rs_pm = u.pm; }
        if (pn < 8) {
            const int head = pn & 3; const bool isk = pn >= 4;
            bf16_t* plane = act + (isk ? (size_t)MTOK * 1024 : (size_t)0);
            const float osc = isk ? 0.0625f : 1.0f;
            float invf[8];
#pragma unroll
            for (int q = 0; q < 8; ++q) { const int i = wc * 32 + 8 * fq + q; invf[q] = __builtin_amdgcn_exp2f(-(float)i * (13.287712379549449f / 128.0f)) * 0.15915494309189535f; }
#pragma unroll
            for (int ai = 0; ai < 2; ++ai)
#pragma unroll
                for (int m = 0; m < 4; ++m) {
                    const int row = row0 + ai * HALF + m * 16; const float rstd = rs8[ai * 4 + m]; const float pos = (float)(row & (SEQ - 1));
                    float o1[8], o2[8];
#pragma unroll
                    for (int q = 0; q < 8; ++q) {
                        const float rev = __builtin_amdgcn_fractf(pos * invf[q]);
                        const float sn = __builtin_amdgcn_sinf(rev), cs = __builtin_amdgcn_cosf(rev);
                        const float x1 = acc[ai][0][m][q >> 2][q & 3] * rstd, x2 = acc[ai][1][m][q >> 2][q & 3] * rstd;
                        o1[q] = (x1 * cs - x2 * sn) * osc; o2[q] = (x1 * sn + x2 * cs) * osc;
                    }
                    bf16_t* rp = plane + (size_t)row * 1024 + head * 256 + wc * 32 + 8 * fq;
                    u32x4 w1, w2;
                    w1.x = cvtpk(o1[0], o1[1]); w1.y = cvtpk(o1[2], o1[3]); w1.z = cvtpk(o1[4], o1[5]); w1.w = cvtpk(o1[6], o1[7]);
                    w2.x = cvtpk(o2[0], o2[1]); w2.y = cvtpk(o2[2], o2[3]); w2.z = cvtpk(o2[4], o2[5]); w2.w = cvtpk(o2[6], o2[7]);
                    *(u32x4*)rp = w1; *(u32x4*)(rp + 128) = w2;
                    asm volatile("" ::: "memory");
                }
        } else {
            const bool isg = pn >= 16; const int t = isg ? pn - 16 : pn - 8;
            bf16_t* plane = act + (size_t)MTOK * (isg ? 4096 : 2048);
#pragma unroll
            for (int ai = 0; ai < 2; ++ai)
#pragma unroll
                for (int m = 0; m < 4; ++m) {
                    const int row = row0 + ai * HALF + m * 16; const float rstd = rs8[ai * 4 + m];
                    bf16_t* rp = plane + (size_t)row * 2048 + t * 256 + wc * 32 + 8 * fq;
#pragma unroll
                    for (int bj = 0; bj < 2; ++bj) { f32x4 v0 = acc[ai][bj][m][0] * rstd, v1 = acc[ai][bj][m][1] * rstd;
                        if (isg) {
#pragma unroll
                            for (int e = 0; e < 4; ++e) { v0[e] *= __builtin_amdgcn_rcpf(1.0f + __builtin_amdgcn_exp2f(-1.4426950408889634f * v0[e])); v1[e] *= __builtin_amdgcn_rcpf(1.0f + __builtin_amdgcn_exp2f(-1.4426950408889634f * v1[e])); }
                        }
                        u32x4 w; w.x = cvtpk(v0[0], v0[1]); w.y = cvtpk(v0[2], v0[3]); w.z = cvtpk(v1[0], v1[1]); w.w = cvtpk(v1[2], v1[3]);
                        *(u32x4*)(rp + bj * HALF) = w; }
                    asm volatile("" ::: "memory");
                }
        }
    }
};

struct EpiSbProj {
    static constexpr bool PERM = true, AFTER_DRAIN = false, HEAD_HOOK = false;
    bf16_t* act; const float* ssq; const float* qg; const float* kg;
    __device__ __forceinline__ void operator()(const f32x4 (&acc)[2][2][4][2], const Unit& u, int wr, int wc, int fr_, int fq_, float (&rs8)[8], int& rs_pm) const {
        int fr = fr_, fq = fq_; asm volatile("" : "+v"(fr), "+v"(fq));
        const int row0 = u.pm * BM + wr * 64 + fr; const int which = u.pn >> 2, t = u.pn & 3;
        if (u.pm != rs_pm) { row_rstd8(ssq, row0, rs8); rs_pm = u.pm; }
        bf16_t* plane = act + (size_t)which * MTOK * 1024;
        const int colbase = t * 256 + 64 * wc + 8 * fq;
        float g[2][8];
        if (which < 2) { const float* gp = which == 0 ? qg : kg; const float gs = which == 0 ? C2SB : 1.0f;
#pragma unroll
            for (int bj = 0; bj < 2; ++bj)
#pragma unroll
                for (int q = 0; q < 8; ++q) g[bj][q] = gp[32 * bj + 8 * fq + q] * gs;
        }
#pragma unroll
        for (int ai = 0; ai < 2; ++ai)
#pragma unroll
            for (int m = 0; m < 4; ++m) {
                const int row = row0 + ai * HALF + m * 16; const float rstd = rs8[ai * 4 + m];
                float v[2][8];
#pragma unroll
                for (int bj = 0; bj < 2; ++bj)
#pragma unroll
                    for (int q = 0; q < 8; ++q) v[bj][q] = acc[ai][bj][m][q >> 2][q & 3] * rstd;
                if (which < 2) {
                    float ss = 0.f;
#pragma unroll
                    for (int bj = 0; bj < 2; ++bj)
#pragma unroll
                        for (int q = 0; q < 8; ++q) ss += v[bj][q] * v[bj][q];
                    ss += __shfl_xor(ss, 16); ss += __shfl_xor(ss, 32);
                    const float rn = rsqrtf(ss * (1.0f / 64.0f) + EPSN);
#pragma unroll
                    for (int bj = 0; bj < 2; ++bj)
#pragma unroll
                        for (int q = 0; q < 8; ++q) v[bj][q] = v[bj][q] * rn * g[bj][q];
                }
                bf16_t* rp = plane + (size_t)row * 1024 + colbase;
#pragma unroll
                for (int bj = 0; bj < 2; ++bj) { u32x4 w; w.x = cvtpk(v[bj][0], v[bj][1]); w.y = cvtpk(v[bj][2], v[bj][3]); w.z = cvtpk(v[bj][4], v[bj][5]); w.w = cvtpk(v[bj][6], v[bj][7]);
                    *(u32x4*)(rp + 32 * bj) = w; }
                asm volatile("" ::: "memory");
            }
    }
};

struct EpiFfnIn {
    static constexpr bool PERM = true, AFTER_DRAIN = false, HEAD_HOOK = false;
    bf16_t* hbuf; const float* ssq;
    __device__ __forceinline__ void operator()(const f32x4 (&acc)[2][2][4][2], const Unit& u, int wr, int wc, int fr_, int fq_, float (&rs8)[8], int& rs_pm) const {
        int fr = fr_, fq = fq_; asm volatile("" : "+v"(fr), "+v"(fq));
        const int row0 = u.pm * BM + wr * 64 + fr;
        if (u.pm != rs_pm) { row_rstd8(ssq, row0, rs8); rs_pm = u.pm; }
#pragma unroll
        for (int ai = 0; ai < 2; ++ai)
#pragma unroll
            for (int m = 0; m < 4; ++m) {
                const int row = row0 + ai * HALF + m * 16; const float rstd = rs8[ai * 4 + m];
                float hv[8];
#pragma unroll
                for (int q = 0; q < 8; ++q) { const float gt = acc[ai][0][m][q >> 2][q & 3] * rstd, up = acc[ai][1][m][q >> 2][q & 3] * rstd;
                    hv[q] = gt * __builtin_amdgcn_rcpf(1.0f + __builtin_amdgcn_exp2f(-1.4426950408889634f * gt)) * up; }
                u32x4 w; w.x = cvtpk(hv[0], hv[1]); w.y = cvtpk(hv[2], hv[3]); w.z = cvtpk(hv[4], hv[5]); w.w = cvtpk(hv[6], hv[7]);
                *(u32x4*)(hbuf + (size_t)row * FFH + u.pn * 128 + wc * 32 + 8 * fq) = w;
                asm volatile("" ::: "memory");
            }
    }
};

struct EpiResid {
    static constexpr bool PERM = true, AFTER_DRAIN = false, HEAD_HOOK = true;
    float* out;
    bf16_t* xb; float* ssq;
    const float* hss;
    __device__ __forceinline__ bool hook_on() const { return hss != nullptr; }
    __device__ __forceinline__ float head_rstd(int row, int h) const {
        const f32x4 sp = *(const f32x4*)(hss + (size_t)row * 16 + h * 4);
        return rsqrtf(((sp[0] + sp[1]) + (sp[2] + sp[3])) * (1.0f / 512.0f) + EPSN);
    }
    __device__ __forceinline__ void rescale(f32x4 (&acc)[2][2][4][2], const Unit& u, int wr, int fr_, int hnext) const {
        int fr = fr_; asm volatile("" : "+v"(fr));
        const float* hp = hss + (size_t)(u.pm * BM + wr * 64 + fr) * 16 + (hnext - 1) * 4;
#pragma unroll
        for (int half = 0; half < 2; ++half) {
            f32x4 s0[4], s1[4];
#pragma unroll
            for (int m = 0; m < 4; ++m) { const float* p = hp + (size_t)(half * HALF + m * 16) * 16; s0[m] = *(const f32x4*)p; s1[m] = *(const f32x4*)(p + 4); }
#pragma unroll
            for (int m = 0; m < 4; ++m) {
                const float a = ((s0[m][0] + s0[m][1]) + (s0[m][2] + s0[m][3])) * (1.0f / 512.0f) + EPSN, b = ((s1[m][0] + s1[m][1]) + (s1[m][2] + s1[m][3])) * (1.0f / 512.0f) + EPSN;
                const float r = sqrtf(b * __builtin_amdgcn_rcpf(a));
#pragma unroll
                for (int bj = 0; bj < 2; ++bj) { acc[half][bj][m][0] = acc[half][bj][m][0] * r; acc[half][bj][m][1] = acc[half][bj][m][1] * r; }
            }
        }
    }
    __device__ __forceinline__ void operator()(const f32x4 (&acc)[2][2][4][2], const Unit& u, int wr, int wc, int fr_, int fq_, float (&rs8)[8], int& rs_pm) const {
        int fr = fr_, fq = fq_; asm volatile("" : "+v"(fr), "+v"(fq));
        const int row0 = u.pm * BM + wr * 64 + fr;
        const size_t coff = (size_t)u.pn * BM + wc * 32 + 8 * fq;
#pragma unroll
        for (int half = 0; half < 2; ++half) {
            u32x4 nb[4][2]; float fsv[4];
#pragma unroll
            for (int m = 0; m < 4; ++m) { const int row = row0 + half * HALF + m * 16; const bf16_t* bp = xb + (size_t)row * DM + coff;
                nb[m][0] = *(const u32x4*)bp; nb[m][1] = *(const u32x4*)(bp + HALF); fsv[m] = hss ? head_rstd(row, 3) : 1.0f; }
#pragma unroll
            for (int m = 0; m < 4; ++m) {
                const int row = row0 + half * HALF + m * 16; float s = 0.f; const float fs = fsv[m];
#pragma unroll
                for (int bj = 0; bj < 2; ++bj) {
                    const size_t off = (size_t)row * DM + coff + bj * HALF;
                    const u32x4 cb = nb[m][bj];
                    const f32x4 b0 = (f32x4){bflo(cb.x), bfhi(cb.x), bflo(cb.y), bfhi(cb.y)}, b1 = (f32x4){bflo(cb.z), bfhi(cb.z), bflo(cb.w), bfhi(cb.w)};
                    const f32x4 v0 = b0 + acc[half][bj][m][0] * fs, v1 = b1 + acc[half][bj][m][1] * fs;
                    if (out) { *(f32x4*)(out + off) = v0; *(f32x4*)(out + off + 4) = v1; }
                    else {
                        u32x4 w; w.x = cvtpk(v0[0], v0[1]); w.y = cvtpk(v0[2], v0[3]); w.z = cvtpk(v1[0], v1[1]); w.w = cvtpk(v1[2], v1[3]);
                        *(u32x4*)(xb + off) = w;
                        s += (v0[0] * v0[0] + v0[1] * v0[1]) + (v0[2] * v0[2] + v0[3] * v0[3]) + (v1[0] * v1[0] + v1[1] * v1[1]) + (v1[2] * v1[2] + v1[3] * v1[3]);
                    }
                }
                if (!out) { s += __shfl_xor(s, 16); s += __shfl_xor(s, 32); if (fq == 0) ssq[(size_t)row * 16 + u.pn * 4 + wc] = s; }
            }
            asm volatile("" ::: "memory");
        }
    }
};
}

#define LAS __attribute__((address_space(3)))
typedef unsigned short bf16_t;
typedef short bf16x8 __attribute__((ext_vector_type(8)));
typedef short s16x4 __attribute__((ext_vector_type(4)));
typedef float f32x4 __attribute__((ext_vector_type(4)));
typedef float f32x16 __attribute__((ext_vector_type(16)));
typedef unsigned u32x4 __attribute__((ext_vector_type(4)));
typedef unsigned u32x2 __attribute__((ext_vector_type(2)));
using pg8::cvtpk; using pg8::bflo; using pg8::bfhi;
#define MFMA16(a, b, c) __builtin_amdgcn_mfma_f32_16x16x32_bf16((a), (b), (c), 0, 0, 0)
#define MFMA32(a, b, c) __builtin_amdgcn_mfma_f32_32x32x16_bf16((a), (b), (c), 0, 0, 0)
__device__ __forceinline__ s16x4 trrd(LAS unsigned char* p) { return __builtin_bit_cast(s16x4, __builtin_amdgcn_ds_read_tr16_b64_v4i16((LAS s16x4*)p)); }
__device__ __forceinline__ bf16x8 cat8(s16x4 lo, s16x4 hi) { return __builtin_shufflevector(lo, hi, 0, 1, 2, 3, 4, 5, 6, 7); }

#define XB_TMO      128
#define XB_XCNT(j)  (256  + 64 * (j))
#define XB_XSUB(j)  (1280 + 64 * (j))
#define XB_XGEN(j)  (2304 + 64 * (j))
#define XB_TOP      3328
#define XB_TOPGEN   3392
#define XCD_BAR_WORDS 3456
#define XB_SPIN_CAP (1u << 18)

__device__ __forceinline__ unsigned xb_ld(unsigned* p)              { return __hip_atomic_load(p, __ATOMIC_RELAXED, __HIP_MEMORY_SCOPE_AGENT); }
__device__ __forceinline__ unsigned xb_add(unsigned* p, unsigned v) { return __hip_atomic_fetch_add(p, v, __ATOMIC_RELAXED, __HIP_MEMORY_SCOPE_AGENT); }
__device__ __forceinline__ unsigned xb_xcc_id() { return (unsigned)__builtin_amdgcn_s_getreg((3 << 11) | 20) & 0xFu; }
#define XB_SPIN(cond, bar) do { unsigned _sp = 0; while (cond) { __builtin_amdgcn_s_sleep(1); \
    if ((++_sp & 255u) == 0u) { if (xb_ld(&(bar)[XB_TMO])) break; if (_sp > XB_SPIN_CAP) { atomicAdd(&(bar)[XB_TMO], 1u); break; } } } } while (0)

struct XcdBarrier {
    unsigned* bar; unsigned x;
    volatile LAS unsigned* st;
};

__device__ __forceinline__ XcdBarrier xcd_barrier_post(unsigned* bar, volatile LAS unsigned* st) {
    XcdBarrier b; b.bar = bar; b.x = xb_xcc_id(); b.st = st;
    if (threadIdx.x == 0) (void)xb_add(&bar[XB_XCNT(b.x)], 1u);
    return b;
}
__device__ __forceinline__ void xcd_barrier_complete(unsigned* bar, unsigned x, unsigned& nloc, unsigned& nx) {
    const unsigned G = gridDim.x * gridDim.y * gridDim.z;
    unsigned sum, cnt, mine, sp = 0u;
    for (;;) {
        sum = 0u; cnt = 0u; mine = 0u;
#pragma unroll
        for (unsigned j = 0; j < 16; ++j) { const unsigned c = xb_ld(&bar[XB_XCNT(j)]); sum += c; cnt += (c > 0u) ? 1u : 0u; mine = (j == x) ? c : mine; }
        if (sum == G) break;
        __builtin_amdgcn_s_sleep(1);
        if ((++sp & 255u) == 0u) { if (xb_ld(&bar[XB_TMO])) break; if (sp > XB_SPIN_CAP) { atomicAdd(&bar[XB_TMO], 1u); break; } }
    }
    nloc = mine > 0u ? mine : 1u; nx = cnt > 0u ? cnt : 1u;
}

__device__ __forceinline__ void xcd_barrier(const XcdBarrier& b) {
    asm volatile("s_waitcnt vmcnt(0)" ::: "memory");
    __syncthreads();
    if (threadIdx.x == 0) {
        unsigned* bar = b.bar;
        __builtin_amdgcn_s_waitcnt(0);
        unsigned nloc = b.st[0], nx = b.st[1];
        if (nloc == 0u) { xcd_barrier_complete(bar, b.x, nloc, nx); b.st[0] = nloc; b.st[1] = nx; }
        const unsigned old = xb_add(&bar[XB_XSUB(b.x)], 1u);
        const unsigned gen = old / nloc;
        if (old + 1u == (gen + 1u) * nloc) {
            __builtin_amdgcn_fence(__ATOMIC_RELEASE, "agent");
            asm volatile("s_waitcnt vmcnt(0)" ::: "memory");
            const unsigned og = xb_add(&bar[XB_TOP], 1u);
            const unsigned tg = og / nx;
            if (og + 1u == (tg + 1u) * nx) xb_add(&bar[XB_TOPGEN], 1u);
            else XB_SPIN(xb_ld(&bar[XB_TOPGEN]) == tg, bar);
            __builtin_amdgcn_fence(__ATOMIC_ACQUIRE, "agent");
            xb_add(&bar[XB_XGEN(b.x)], 1u);
            asm volatile("s_waitcnt vmcnt(0)" ::: "memory");
        } else {
            XB_SPIN(xb_ld(&bar[XB_XGEN(b.x)]) == gen, bar);
            __builtin_amdgcn_fence(__ATOMIC_ACQUIRE, "agent");
            asm volatile("s_waitcnt vmcnt(0)" ::: "memory");
        }
    }
    __syncthreads();
}

constexpr size_t MiB = 1u << 20;
constexpr size_t WS_SSQ = 0;
constexpr size_t WS_SSQP = 2 * MiB;
constexpr size_t WS_W = 4 * MiB;
constexpr size_t W_MI = 0, W_MO = 12 * MiB, W_FI = 16 * MiB, W_FO = 27 * MiB;
constexpr size_t WS_XB = 38 * MiB;
constexpr size_t WS_ACT = 102 * MiB;
constexpr size_t WS_BAR = 486 * MiB;
constexpr size_t WS_RSTD = 486 * MiB + 65536;
constexpr size_t WS_END = 486 * MiB + 65536 + 131072;
constexpr int LDS_BYTES = 147456;

__device__ __forceinline__ int dest_row(int mode, int c) {
    if (mode == 1) { const int pn = c >> 8, l = c & 255; return (pn << 8) + ((l >> 5) & 1) * 128 + (l >> 6) * 32 + (l & 31); }
    if (mode == 2) { const int half = c >= FFH ? 1 : 0; const int hc = c - half * FFH; return ((hc >> 7) << 8) + half * 128 + (hc & 127); }
    return c;
}
__device__ __forceinline__ void transpose_item(const float* W, int K, int N, const float* gain, bf16_t* WT, int mode, LAS float* scr, int item, int lane) {
    const int nblk = N / 64, kb = item / nblk, nb = item % nblk, k0 = 64 * kb, n0 = 64 * nb;
    const int lr = lane >> 4, c4 = (lane & 15) * 4;
#pragma unroll 8
    for (int i = 0; i < 16; ++i) { const int r = 4 * i + lr; const float gv = gain ? gain[k0 + r] : 1.0f;
        const f32x4 v = *(const f32x4*)(W + (size_t)(k0 + r) * N + n0 + c4);
        LAS float* d = scr + r * 65 + c4; d[0] = v[0] * gv; d[1] = v[1] * gv; d[2] = v[2] * gv; d[3] = v[3] * gv; }
    asm volatile("s_waitcnt lgkmcnt(0)" ::: "memory");
    const int c = lane & 7;
#pragma unroll
    for (int j = 0; j < 8; ++j) { const int n = (lane >> 3) + 8 * j; const LAS float* sp = scr + (8 * c) * 65 + n;
        u32x4 o; o.x = cvtpk(sp[0 * 65], sp[1 * 65]); o.y = cvtpk(sp[2 * 65], sp[3 * 65]); o.z = cvtpk(sp[4 * 65], sp[5 * 65]); o.w = cvtpk(sp[6 * 65], sp[7 * 65]);
        *(u32x4*)(WT + (size_t)dest_row(mode, n0 + n) * K + k0 + 8 * c) = o; }
    asm volatile("s_waitcnt lgkmcnt(0)" ::: "memory");
}
struct Args { const float* in[12]; float* out; unsigned char* ws; };
__device__ __forceinline__ void conv_weights(const Args& a, int i, LAS unsigned char* L) {
    const int tid = opaque_tid(), lane = tid & 63, wave = tid >> 6;
    LAS float* scr = (LAS float*)(L + wave * 16640);
    const int gw = blockIdx.x * 8 + wave, NGW = gridDim.x * 8;
    const int j = i >> 1; const bool ret = !(i & 1);
    bf16_t* wbase = (bf16_t*)(a.ws + WS_W);
    const int I_MI = ret ? 16 * 96 : 16 * 48, I_MO = ret ? 32 * 16 : 16 * 16, I_FI = 16 * 88, I_FO = 44 * 16;
    const int total = I_MI + I_MO + I_FI + I_FO;
    for (int it = gw; it < total; it += NGW) {
        int r = it;
        if (r < I_MI) { if (ret) transpose_item(a.in[3] + (size_t)j * 1024 * 6144, 1024, 6144, a.in[1] + i * 1024, wbase + W_MI / 2, 0, scr, r, lane);
                        else     transpose_item(a.in[6] + (size_t)j * 1024 * 3072, 1024, 3072, a.in[1] + i * 1024, wbase + W_MI / 2, 1, scr, r, lane);
                        continue; }
        r -= I_MI;
        if (r < I_MO) { if (ret) transpose_item(a.in[5] + (size_t)j * 2048 * 1024, 2048, 1024, a.in[4] + (size_t)j * 2048, wbase + W_MO / 2, 0, scr, r, lane);
                        else     transpose_item(a.in[9] + (size_t)j * 1024 * 1024, 1024, 1024, nullptr, wbase + W_MO / 2, 0, scr, r, lane);
                        continue; }
        r -= I_MO;
        if (r < I_FI) { transpose_item(a.in[10] + (size_t)i * 1024 * 5632, 1024, 5632, a.in[2] + i * 1024, wbase + W_FI / 2, 2, scr, r, lane); continue; }
        r -= I_FI;
        transpose_item(a.in[11] + (size_t)i * FFH * 1024, FFH, 1024, nullptr, wbase + W_FO / 2, 0, scr, r, lane);
    }
}
__device__ __forceinline__ void x_pass(const float* x, bf16_t* xb, float* rstd) {
    const int tid = opaque_tid(), lane = tid & 63, wave = tid >> 6;
    const int gw = blockIdx.x * 8 + wave, NGW = gridDim.x * 8;
#pragma unroll 2
    for (int m = gw; m < MTOK; m += NGW) {
        const f32x4* xr = (const f32x4*)(x + (size_t)m * DM) + lane;
        f32x4 v[4]; float s = 0.f;
#pragma unroll
        for (int jj = 0; jj < 4; ++jj) { v[jj] = xr[64 * jj]; s += (v[jj][0] * v[jj][0] + v[jj][1] * v[jj][1]) + (v[jj][2] * v[jj][2] + v[jj][3] * v[jj][3]); }
#pragma unroll
        for (int o = 1; o < 64; o <<= 1) s += __shfl_xor(s, o);
        u32x2* o8 = (u32x2*)(xb + (size_t)m * DM) + lane;
#pragma unroll
        for (int jj = 0; jj < 4; ++jj) { u32x2 w; w.x = cvtpk(v[jj][0], v[jj][1]); w.y = cvtpk(v[jj][2], v[jj][3]); o8[64 * jj] = w; }
        if (lane == 0) rstd[m] = rsqrtf(s * (1.0f / 1024.0f) + EPSN);
    }
}

__device__ __forceinline__ void rstd_pass(const float* ssq, float* rstd) {
    const int tid = opaque_tid();
    for (int row = blockIdx.x * 512 + tid; row < MTOK; row += gridDim.x * 512) {
        const f32x4* p = (const f32x4*)(ssq + (size_t)row * 16);
        const f32x4 a = p[0], b = p[1], c = p[2], d = p[3];
        const float s = ((a[0] + a[1]) + (a[2] + a[3])) + ((b[0] + b[1]) + (b[2] + b[3])) + ((c[0] + c[1]) + (c[2] + c[3])) + ((d[0] + d[1]) + (d[2] + d[3]));
        rstd[row] = rsqrtf(s * (1.0f / 1024.0f) + EPSN);
    }
}
constexpr int R_Q = 0, R_K = 34816, R_V = 71680, R_P = 92160, R_O = 101376;
__device__ __forceinline__ float bf2f(short x) { return __uint_as_float(((unsigned)(unsigned short)x) << 16); }
__device__ __forceinline__ void ret_phase(LAS unsigned char* L, const bf16_t* Qp, const bf16_t* Kp, bf16_t* Vp, const bf16_t* Gp, float* ssqp) {
    const int tid0 = opaque_tid(), w = __builtin_amdgcn_readfirstlane(tid0 >> 6);
#define RET_LANES() int tid = tid0; asm volatile("" : "+v"(tid)); const int lane = tid & 63, l15 = lane & 15, quad = lane >> 4, tq = l15 >> 2, tp = l15 & 3; (void)tq; (void)tp; (void)quad; (void)l15
    for (int uidx = blockIdx.x; uidx < 256; uidx += gridDim.x) {
        const int vcu = (uidx & 7) * 32 + (uidx >> 3);
        const int bh = vcu >> 2, vs = vcu & 3, b = bh >> 2, h = bh & 3;
        const float lg = __builtin_amdgcn_logf(1.0f - __builtin_amdgcn_exp2f(-5.0f - (float)h));
        const size_t rowb = (size_t)b * SEQ;
        if (w >= 4) {
            int ht = tid0 - 256; asm volatile("" : "+v"(ht));
            const bf16_t* qsrc = Qp + (rowb + (ht >> 5)) * 1024 + h * 256 + (ht & 31) * 8;
            const bf16_t* ksrc = Kp + (rowb + (ht >> 5)) * 1024 + h * 256 + (ht & 31) * 8;
            bf16_t* vsrc = Vp + (rowb + (ht >> 4)) * 2048 + h * 512 + vs * 128 + (ht & 15) * 8;
            const bf16_t* gsrc = Gp + (rowb + (ht >> 4)) * 2048 + h * 512 + vs * 128 + (ht & 15) * 8;
            u32x4 rq[8], rk[8], rv[4], rg[4];
#pragma unroll
            for (int i = 0; i < 8; ++i) { rq[i] = *(const u32x4*)(qsrc + (size_t)i * 8 * 1024); rk[i] = *(const u32x4*)(ksrc + (size_t)i * 8 * 1024); }
#pragma unroll
            for (int i = 0; i < 4; ++i) rv[i] = *(const u32x4*)(vsrc + (size_t)i * 16 * 2048);
#pragma unroll 1
            for (int n = 0; n < 32; ++n) {
                const size_t row0 = rowb + n * 64;
                { RET_LANES(); const int hl = tid - 256;
#pragma unroll
                for (int i = 0; i < 8; ++i) { *(LAS u32x4*)(L + R_Q + ((hl >> 5) + 8 * i) * 544 + (hl & 31) * 16) = rq[i]; *(LAS u32x4*)(L + R_K + ((hl >> 5) + 8 * i) * 576 + (hl & 31) * 16) = rk[i]; }
#pragma unroll
                for (int i = 0; i < 4; ++i) *(LAS u32x4*)(L + R_V + ((hl >> 4) + 16 * i) * 320 + (hl & 15) * 16) = rv[i];
                }
                __syncthreads();
#pragma unroll
                for (int i = 0; i < 4; ++i) rg[i] = *(const u32x4*)(gsrc + ((size_t)n * 64 + 16 * i) * 2048);
                if (n < 31) {
                    const size_t adv = (size_t)(n + 1) * 64;
#pragma unroll
                    for (int i = 0; i < 8; ++i) { rq[i] = *(const u32x4*)(qsrc + (adv + 8 * i) * 1024); rk[i] = *(const u32x4*)(ksrc + (adv + 8 * i) * 1024); }
#pragma unroll
                    for (int i = 0; i < 4; ++i) rv[i] = *(const u32x4*)(vsrc + (adv + 16 * i) * 2048);
                }
                __builtin_amdgcn_sched_barrier(0);
                { RET_LANES();
                const int cb = w - 4;
                f32x4 sc[4];
#pragma unroll
                for (int eb = 0; eb < 4; ++eb) sc[eb] = (f32x4){0.f, 0.f, 0.f, 0.f};
#pragma unroll
                for (int ks = 0; ks < 8; ++ks) {
                    const bf16x8 a = *(const LAS bf16x8*)(L + R_Q + (16 * cb + l15) * 544 + (32 * ks + 8 * quad) * 2);
                    bf16x8 kf[4];
#pragma unroll
                    for (int eb = 0; eb < 4; ++eb) kf[eb] = *(const LAS bf16x8*)(L + R_K + (16 * eb + l15) * 576 + (32 * ks + 8 * quad) * 2);
#pragma unroll
                    for (int eb = 0; eb < 4; ++eb) sc[eb] = MFMA16(kf[eb], a, sc[eb]);
                }
                const int c = 16 * cb + l15;
#pragma unroll
                for (int eb = 0; eb < 4; ++eb) { float p[4];
#pragma unroll
                    for (int i = 0; i < 4; ++i) { const int e = 16 * eb + 4 * quad + i; const float d = (float)(c > e ? c - e : e - c); p[i] = sc[eb][i] * __builtin_amdgcn_exp2f(lg * d); }
                    u32x2 pw; pw.x = cvtpk(p[0], p[1]); pw.y = cvtpk(p[2], p[3]);
                    *(LAS u32x2*)(L + R_P + c * 144 + (16 * eb + 4 * quad) * 2) = pw; }
                }
                __syncthreads();
                __syncthreads();
                { RET_LANES(); const int hl = tid - 256;
#pragma unroll
                for (int i = 0; i < 4; ++i) {
                    const int row = (hl >> 4) + 16 * i;
                    const u32x4 o = *(const LAS u32x4*)(L + R_O + row * 272 + (hl & 15) * 16);
                    const u32x4 g = rg[i];
                    const float ov[8] = {bflo(o.x), bfhi(o.x), bflo(o.y), bfhi(o.y), bflo(o.z), bfhi(o.z), bflo(o.w), bfhi(o.w)};
                    const float gv[8] = {bflo(g.x), bfhi(g.x), bflo(g.y), bfhi(g.y), bflo(g.z), bfhi(g.z), bflo(g.w), bfhi(g.w)};
                    float ss = 0.f; float y[8];
#pragma unroll
                    for (int q = 0; q < 8; ++q) { ss += ov[q] * ov[q]; y[q] = ov[q] * gv[q]; }
                    u32x4 yv; yv.x = cvtpk(y[0], y[1]); yv.y = cvtpk(y[2], y[3]); yv.z = cvtpk(y[4], y[5]); yv.w = cvtpk(y[6], y[7]);
                    *(u32x4*)(vsrc + ((size_t)n * 64 + 16 * i) * 2048) = yv;
                    ss += __shfl_xor(ss, 1); ss += __shfl_xor(ss, 2); ss += __shfl_xor(ss, 4); ss += __shfl_xor(ss, 8);
                    if ((hl & 15) == 0) ssqp[(row0 + row) * 16 + h * 4 + vs] = ss;
                }
                }
            }
        } else {
            const float ginv = __builtin_amdgcn_exp2f(-lg);
            const float cdec = __builtin_amdgcn_exp2f(lg * 64.0f);
            f32x4 S[2][16];
#pragma unroll
            for (int nb = 0; nb < 2; ++nb)
#pragma unroll
                for (int k = 0; k < 16; ++k) S[nb][k] = (f32x4){0.f, 0.f, 0.f, 0.f};
#pragma unroll 1
            for (int n = 0; n < 32; ++n) {
                __syncthreads();
                f32x4 oa[4][2];
                { RET_LANES();
#pragma unroll
                for (int cb = 0; cb < 4; ++cb) { oa[cb][0] = (f32x4){0.f, 0.f, 0.f, 0.f}; oa[cb][1] = oa[cb][0]; }
                const LAS unsigned char* qb = L + R_Q + l15 * 544 + (8 * quad) * 2;
                bf16x8 qa[2][4];
#pragma unroll
                for (int cb = 0; cb < 4; ++cb) qa[0][cb] = *(const LAS bf16x8*)(qb + cb * 16 * 544);
#pragma unroll
                for (int ks = 0; ks < 8; ++ks) {
                    const int cu = ks & 1, nx = cu ^ 1;
                    if (ks < 7) {
#pragma unroll
                        for (int cb = 0; cb < 4; ++cb) qa[nx][cb] = *(const LAS bf16x8*)(qb + cb * 16 * 544 + (ks + 1) * 64);
                    }
                    __builtin_amdgcn_sched_barrier(0);
                    bf16x8 bst[2];
#pragma unroll
                    for (int nb = 0; nb < 2; ++nb) { u32x4 bp; bp.x = cvtpk(S[nb][2 * ks][0], S[nb][2 * ks][1]); bp.y = cvtpk(S[nb][2 * ks][2], S[nb][2 * ks][3]); bp.z = cvtpk(S[nb][2 * ks + 1][0], S[nb][2 * ks + 1][1]); bp.w = cvtpk(S[nb][2 * ks + 1][2], S[nb][2 * ks + 1][3]);
                        bst[nb] = __builtin_bit_cast(bf16x8, bp); }
#pragma unroll
                    for (int cb = 0; cb < 4; ++cb) { oa[cb][0] = MFMA16(bst[0], qa[cu][cb], oa[cb][0]); oa[cb][1] = MFMA16(bst[1], qa[cu][cb], oa[cb][1]); }
                    __builtin_amdgcn_sched_barrier(0);
                }
#pragma unroll
                for (int cb = 0; cb < 4; ++cb) { const float dc = __builtin_amdgcn_exp2f(lg * (float)(16 * cb + l15 + 1)); oa[cb][0] = oa[cb][0] * dc; oa[cb][1] = oa[cb][1] * dc; }
                }
                __builtin_amdgcn_sched_barrier(0);
                bf16x8 bvs[2][2];
                { RET_LANES();
#pragma unroll
                for (int ks = 0; ks < 2; ++ks)
#pragma unroll
                    for (int nb = 0; nb < 2; ++nb) {
                        const s16x4 vlo = trrd(L + R_V + (32 * ks + 8 * quad + tq) * 320 + (32 * w + 16 * nb + 4 * tp) * 2);
                        const s16x4 vhi = trrd(L + R_V + (32 * ks + 8 * quad + 4 + tq) * 320 + (32 * w + 16 * nb + 4 * tp) * 2);
                        float dj = __builtin_amdgcn_exp2f(lg * (float)(63 - 32 * ks - 8 * quad));
                        float f[8] = {bf2f(vlo[0]), bf2f(vlo[1]), bf2f(vlo[2]), bf2f(vlo[3]), bf2f(vhi[0]), bf2f(vhi[1]), bf2f(vhi[2]), bf2f(vhi[3])};
#pragma unroll
                        for (int q = 0; q < 8; ++q) { f[q] *= dj; dj *= ginv; }
                        u32x4 sv; sv.x = cvtpk(f[0], f[1]); sv.y = cvtpk(f[2], f[3]); sv.z = cvtpk(f[4], f[5]); sv.w = cvtpk(f[6], f[7]);
                        bvs[ks][nb] = __builtin_bit_cast(bf16x8, sv);
                    }
                }
                __builtin_amdgcn_sched_barrier(0);
                { RET_LANES();
#pragma unroll
                for (int nb = 0; nb < 2; ++nb)
#pragma unroll
                    for (int k = 0; k < 16; ++k) S[nb][k] = S[nb][k] * cdec;
                const LAS unsigned char* kb = L + R_K + (8 * quad + tq) * 576 + (8 * tp) * 2;
                s16x4 klo[2][4], khi[2][4];
#pragma unroll
                for (int kk = 0; kk < 4; ++kk) { klo[0][kk] = trrd((LAS unsigned char*)kb + (kk >> 1) * 64 + (kk & 1) * 8); khi[0][kk] = trrd((LAS unsigned char*)kb + 4 * 576 + (kk >> 1) * 64 + (kk & 1) * 8); }
#pragma unroll
                for (int g = 0; g < 8; ++g) {
                    const int cu = g & 1, nx = cu ^ 1;
                    if (g < 7) { const int ks1 = (g + 1) >> 2, k41 = (g + 1) & 3;
#pragma unroll
                        for (int kk = 0; kk < 4; ++kk) { klo[nx][kk] = trrd((LAS unsigned char*)kb + ks1 * 32 * 576 + ((4 * k41 + kk) >> 1) * 64 + (kk & 1) * 8); khi[nx][kk] = trrd((LAS unsigned char*)kb + ks1 * 32 * 576 + 4 * 576 + ((4 * k41 + kk) >> 1) * 64 + (kk & 1) * 8); }
                    }
                    __builtin_amdgcn_sched_barrier(0);
#pragma unroll
                    for (int kk = 0; kk < 4; ++kk) { const bf16x8 ka = cat8(klo[cu][kk], khi[cu][kk]);
                        S[0][4 * (g & 3) + kk] = MFMA16(ka, bvs[g >> 2][0], S[0][4 * (g & 3) + kk]); S[1][4 * (g & 3) + kk] = MFMA16(ka, bvs[g >> 2][1], S[1][4 * (g & 3) + kk]); }
                    __builtin_amdgcn_sched_barrier(0);
                }
                }
                __syncthreads();
                { RET_LANES();
#pragma unroll
                for (int ks = 0; ks < 2; ++ks) {
                    bf16x8 pa[4];
#pragma unroll
                    for (int cb = 0; cb < 4; ++cb) pa[cb] = *(const LAS bf16x8*)(L + R_P + (16 * cb + l15) * 144 + (32 * ks + 8 * quad) * 2);
#pragma unroll
                    for (int nb = 0; nb < 2; ++nb) {
                        const s16x4 vlo = trrd(L + R_V + (32 * ks + 8 * quad + tq) * 320 + (32 * w + 16 * nb + 4 * tp) * 2);
                        const s16x4 vhi = trrd(L + R_V + (32 * ks + 8 * quad + 4 + tq) * 320 + (32 * w + 16 * nb + 4 * tp) * 2);
                        const bf16x8 bv = cat8(vlo, vhi);
#pragma unroll
                        for (int cb = 0; cb < 4; ++cb) oa[cb][nb] = MFMA16(bv, pa[cb], oa[cb][nb]);
                    }
                }
#pragma unroll
                for (int cb = 0; cb < 4; ++cb)
#pragma unroll
                    for (int nb = 0; nb < 2; ++nb) { u32x2 ow; ow.x = cvtpk(oa[cb][nb][0], oa[cb][nb][1]); ow.y = cvtpk(oa[cb][nb][2], oa[cb][nb][3]);
                        *(LAS u32x2*)(L + R_O + (16 * cb + l15) * 272 + (32 * w + 16 * nb + 4 * quad) * 2) = ow; }
                }
                __syncthreads();
            }
        }
        __syncthreads();
    }
}
#undef RET_LANES
constexpr int SB_KP = 144, SB_VP = 192, SB_KS = 64 * SB_KP, SB_VS = 64 * SB_VP, SB_VOFF = 6 * SB_KS, SB_FLAG = SB_VOFF + 6 * SB_VS;
constexpr float SB_STOP = 1.0995116e12f;
__device__ __forceinline__ void sb_tile(LAS unsigned char* Kb, LAS unsigned char* Vb, const bf16x8 (&qf)[4], f32x16& o0, f32x16& o1, float& carry,
                                        int kt, int q0, int qabs, int pir, int hf, int g1, int tq, int tp) {
    f32x16 s0, s1;
#pragma unroll
    for (int i = 0; i < 16; ++i) { s0[i] = 0.f; s1[i] = 0.f; }
#pragma unroll
    for (int ks = 0; ks < 4; ++ks) {
        const bf16x8 a0 = *(const LAS bf16x8*)(Kb + pir * SB_KP + (16 * ks + 8 * hf) * 2);
        const bf16x8 a1 = *(const LAS bf16x8*)(Kb + (pir + 16) * SB_KP + (16 * ks + 8 * hf) * 2);
        s0 = MFMA32(a0, qf[ks], s0); s1 = MFMA32(a1, qf[ks], s1);
    }
    const int kbase = 64 * kt + 32 * hf;
    if (64 * kt + 63 >= q0) {
#pragma unroll
        for (int i = 0; i < 16; ++i) { if (!(kbase + i < qabs)) s0[i] = -1e30f; if (!(kbase + 16 + i < qabs)) s1[i] = -1e30f; }
    }
    float dl = 1.0f;
#pragma unroll
    for (int i = 15; i >= 0; --i) { const float e = __builtin_amdgcn_exp2f(s1[i]); dl *= (1.0f + e); s1[i] = e * __builtin_amdgcn_rcpf(dl); }
#pragma unroll
    for (int i = 15; i >= 0; --i) { const float e = __builtin_amdgcn_exp2f(s0[i]); dl *= (1.0f + e); s0[i] = e * __builtin_amdgcn_rcpf(dl); }
    const float pdl = __shfl_xor(dl, 32);
    const float fac = __builtin_amdgcn_rcpf(carry * (hf == 0 ? pdl : 1.0f));
    carry = carry * dl * pdl;
#pragma unroll
    for (int mb = 0; mb < 2; ++mb)
#pragma unroll
        for (int s = 0; s < 2; ++s) {
            u32x4 pw;
            if (mb == 0) { pw.x = cvtpk(s0[8 * s + 0] * fac, s0[8 * s + 1] * fac); pw.y = cvtpk(s0[8 * s + 2] * fac, s0[8 * s + 3] * fac); pw.z = cvtpk(s0[8 * s + 4] * fac, s0[8 * s + 5] * fac); pw.w = cvtpk(s0[8 * s + 6] * fac, s0[8 * s + 7] * fac); }
            else         { pw.x = cvtpk(s1[8 * s + 0] * fac, s1[8 * s + 1] * fac); pw.y = cvtpk(s1[8 * s + 2] * fac, s1[8 * s + 3] * fac); pw.z = cvtpk(s1[8 * s + 4] * fac, s1[8 * s + 5] * fac); pw.w = cvtpk(s1[8 * s + 6] * fac, s1[8 * s + 7] * fac); }
            const bf16x8 pk = __builtin_bit_cast(bf16x8, pw);
            const int krow = 32 * hf + 16 * mb + 8 * s + tq;
            { const s16x4 vlo = trrd(Vb + krow * SB_VP + (16 * g1 + 4 * tp) * 2), vhi = trrd(Vb + (krow + 4) * SB_VP + (16 * g1 + 4 * tp) * 2);
              o0 = MFMA32(cat8(vlo, vhi), pk, o0); }
            { const s16x4 vlo = trrd(Vb + krow * SB_VP + (32 + 16 * g1 + 4 * tp) * 2), vhi = trrd(Vb + (krow + 4) * SB_VP + (32 + 16 * g1 + 4 * tp) * 2);
              o1 = MFMA32(cat8(vlo, vhi), pk, o1); }
        }
}
__device__ __forceinline__ void sb_phase(LAS unsigned char* L, const bf16_t* Qp, const bf16_t* Kp, const bf16_t* Vp, bf16_t* Op) {
    const int tid = opaque_tid(), lane = tid & 63, w = __builtin_amdgcn_readfirstlane(tid >> 6), n = lane & 31, hf = lane >> 5, g1 = (lane >> 4) & 1, tq = (lane & 15) >> 2, tp = lane & 3;
    const int pir = 32 * ((n >> 2) & 1) + (n & 3) + 4 * (n >> 3);
    const int sr = tid >> 3, sch = tid & 7;
    LAS unsigned* flags = (LAS unsigned*)(L + SB_FLAG);
    for (int bh = blockIdx.x; bh < 256; bh += gridDim.x) {
        const int b = bh >> 4, h = bh & 15;
        const size_t tb = (size_t)b * SEQ;
        const bf16_t* kcol = Kp + (tb + sr) * 1024 + h * 64 + sch * 8;
        const bf16_t* vcol = Vp + (tb + sr) * 1024 + h * 64 + sch * 8;
        u32x4 kreg[6], vreg[6]; bf16x8 qn[4];
#pragma unroll
        for (int ks = 0; ks < 4; ++ks) qn[ks] = *(const bf16x8*)(Qp + (tb + 256 * 7 + 32 * w + n) * 1024 + h * 64 + 16 * ks + 8 * hf);
        { const int lo = 4 * 7 - 2;
#pragma unroll
          for (int j = 0; j < 6; ++j) { kreg[j] = *(const u32x4*)(kcol + (size_t)(lo + j) * 64 * 1024); vreg[j] = *(const u32x4*)(vcol + (size_t)(lo + j) * 64 * 1024); } }
#pragma unroll 1
        for (int kq = 7; kq >= 0; --kq) {
            int lo = 4 * kq - 2; if (lo < 0) lo = 0;
            const int q0 = 256 * kq + 32 * w, qabs = q0 + n;
            bf16x8 qf[4];
#pragma unroll
            for (int ks = 0; ks < 4; ++ks) qf[ks] = qn[ks];
#pragma unroll
            for (int j = 0; j < 6; ++j) { *(LAS u32x4*)(L + j * SB_KS + sr * SB_KP + sch * 16) = kreg[j]; *(LAS u32x4*)(L + SB_VOFF + j * SB_VS + sr * SB_VP + sch * 16) = vreg[j]; }
            __syncthreads();
            if (kq > 0) { int nlo = 4 * (kq - 1) - 2; if (nlo < 0) nlo = 0; const int ncnt = 4 * (kq - 1) + 4 - nlo;
#pragma unroll
                for (int ks = 0; ks < 4; ++ks) qn[ks] = *(const bf16x8*)(Qp + (tb + 256 * (kq - 1) + 32 * w + n) * 1024 + h * 64 + 16 * ks + 8 * hf);
#pragma unroll
                for (int j = 0; j < 6; ++j) if (j < ncnt) { kreg[j] = *(const u32x4*)(kcol + (size_t)(nlo + j) * 64 * 1024); vreg[j] = *(const u32x4*)(vcol + (size_t)(nlo + j) * 64 * 1024); } }
            f32x16 o0, o1;
#pragma unroll
            for (int i = 0; i < 16; ++i) { o0[i] = 0.f; o1[i] = 0.f; }
            float carry = 1.0f;
            int kt = (q0 + 30) >> 6; bool done = false;
#pragma unroll 1
            for (; kt >= lo; --kt) {
                sb_tile(L + (kt - lo) * SB_KS, L + SB_VOFF + (kt - lo) * SB_VS, qf, o0, o1, carry, kt, q0, qabs, pir, hf, g1, tq, tp);
                if (__all(carry >= SB_STOP)) { done = true; break; }
            }
            bool need = !done && lo > 0;
            if (lane == 0) flags[w] = need ? 1u : 0u;
            __syncthreads();
            int flo = lo;
#pragma unroll 1
            for (;;) {
                unsigned any = 0;
#pragma unroll
                for (int q = 0; q < 8; ++q) any |= flags[q];
                if (!any) break;
                --flo;
                const u32x4 kx = *(const u32x4*)(kcol + (size_t)flo * 64 * 1024), vx = *(const u32x4*)(vcol + (size_t)flo * 64 * 1024);
                __syncthreads();
                *(LAS u32x4*)(L + sr * SB_KP + sch * 16) = kx; *(LAS u32x4*)(L + SB_VOFF + sr * SB_VP + sch * 16) = vx;
                __syncthreads();
                if (need) {
                    sb_tile(L, L + SB_VOFF, qf, o0, o1, carry, flo, q0, qabs, pir, hf, g1, tq, tp);
                    if (__all(carry >= SB_STOP) || flo == 0) need = false;
                }
                if (lane == 0) flags[w] = need ? 1u : 0u;
                __syncthreads();
            }
            bf16_t* orow = Op + (tb + qabs) * 1024 + h * 64;
#pragma unroll
            for (int g4 = 0; g4 < 4; ++g4) {
                u32x2 w0, w1; w0.x = cvtpk(o0[4 * g4], o0[4 * g4 + 1]); w0.y = cvtpk(o0[4 * g4 + 2], o0[4 * g4 + 3]); w1.x = cvtpk(o1[4 * g4], o1[4 * g4 + 1]); w1.y = cvtpk(o1[4 * g4 + 2], o1[4 * g4 + 3]);
                *(u32x2*)(orow + 8 * g4 + 4 * hf) = w0; *(u32x2*)(orow + 32 + 8 * g4 + 4 * hf) = w1;
            }
        }
        __syncthreads();
    }
}

__global__ void __launch_bounds__(512, 2) fwd_kernel(Args a) {
    extern __shared__ __attribute__((aligned(16))) unsigned char lds[];
    LAS unsigned char* L = (LAS unsigned char*)lds;
    cg::grid_group grid = cg::this_grid();
    const int G = gridDim.x, bx = blockIdx.x;
    { unsigned char* ws0 = a.ws; x_pass(a.in[0], (bf16_t*)(ws0 + WS_XB), (float*)(ws0 + WS_RSTD)); }
    conv_weights(a, 0, L);
    unsigned* barw = (unsigned*)(a.ws + WS_BAR);
    volatile LAS unsigned* bst = (volatile LAS unsigned*)(L + LDS_BYTES - 64);
    if (bx == 0) { for (int u = threadIdx.x; u < XCD_BAR_WORDS; u += 512) barw[u] = 0u; }
    if (threadIdx.x < 2) bst[threadIdx.x] = 0u;
    grid.sync();
    const XcdBarrier bar = xcd_barrier_post(barw, bst);
#define GSYNC() xcd_barrier(bar)
#pragma unroll 1
    for (int i = 0; i < 4; ++i) {
        const int j = i >> 1; const bool ret = !(i & 1);
        if (i > 0) { conv_weights(a, i, L); rstd_pass((const float*)(a.ws + WS_SSQ), (float*)(a.ws + WS_RSTD)); GSYNC(); }
        size_t zoff = 0; asm volatile("" : "+s"(zoff)); unsigned char* ws = a.ws + zoff;
        float* ssq = (float*)(ws + WS_SSQ); float* ssqp = (float*)(ws + WS_SSQP); float* rstd = (float*)(ws + WS_RSTD);
        bf16_t* wb = (bf16_t*)(ws + WS_W); bf16_t* xb = (bf16_t*)(ws + WS_XB); bf16_t* act = (bf16_t*)(ws + WS_ACT);
        bf16_t* W_mi = wb + W_MI / 2; bf16_t* W_mo = wb + W_MO / 2; bf16_t* W_fi = wb + W_FI / 2; bf16_t* W_fo = wb + W_FO / 2;
        const bf16_t* moA; int moK;
        if (ret) {
            { pg8::Gemm g{xb, W_mi, MTOK, 6144, 1024}; pg8::StaticOrder S; S.init(MTOK, 6144, G, bx);
              pg8::EpiRetProj E{act, rstd};
              pg8::gemm_phase<pg8::EpiRetProj, pg8::StaticOrder, true, true>(L, g, S, E); }
            GSYNC();
            ret_phase(L, act, act + (size_t)MTOK * 1024, act + (size_t)MTOK * 2048, act + (size_t)MTOK * 4096, ssqp);
            GSYNC();
            moA = act + (size_t)MTOK * 2048; moK = 2048;
        } else {
            { pg8::Gemm g{xb, W_mi, MTOK, 3072, 1024}; pg8::StaticOrder S; S.init(MTOK, 3072, G, bx);
              pg8::EpiSbProj E{act, rstd, a.in[7] + j * 64, a.in[8] + j * 64};
              pg8::gemm_phase<pg8::EpiSbProj, pg8::StaticOrder, true, true>(L, g, S, E); }
            GSYNC();
            sb_phase(L, act, act + (size_t)MTOK * 1024, act + (size_t)MTOK * 2048, act + (size_t)MTOK * 3072);
            GSYNC();
            moA = act + (size_t)MTOK * 3072; moK = 1024;
        }
        { pg8::Gemm g{moA, W_mo, MTOK, 1024, moK}; pg8::StaticOrder S; S.init(MTOK, 1024, G, bx);
          pg8::EpiResid E{nullptr, xb, ssq, ret ? ssqp : nullptr};
          pg8::gemm_phase<pg8::EpiResid, pg8::StaticOrder, true, true>(L, g, S, E); }
        GSYNC();
        rstd_pass(ssq, rstd);
        GSYNC();
        { pg8::Gemm g{xb, W_fi, MTOK, 2 * FFH, 1024}; pg8::StaticOrder S; S.init(MTOK, 2 * FFH, G, bx);
          pg8::EpiFfnIn E{act, rstd};
          pg8::gemm_phase<pg8::EpiFfnIn, pg8::StaticOrder, true, true>(L, g, S, E); }
        GSYNC();
        { pg8::Gemm g{act, W_fo, MTOK, 1024, FFH}; pg8::StaticOrder S; S.init(MTOK, 1024, G, bx);
          pg8::EpiResid E{(i < 3) ? nullptr : a.out, xb, ssq, nullptr};
          pg8::gemm_phase<pg8::EpiResid, pg8::StaticOrder, true, true>(L, g, S, E); }
        if (i < 3) GSYNC();
    }
}

extern "C" void kernel_launch(void* const* d_in, const int* in_sizes, int n_in, void* d_out, int out_size, void* d_ws, size_t ws_size, hipStream_t stream) {
    static int grid_blocks = 0;
    if (grid_blocks == 0) {
        if (n_in != 12 || out_size != MTOK * DM || ws_size < WS_END) { fprintf(stderr, "kernel_launch: unexpected shapes (n_in %d out %d ws %zu)\n", n_in, out_size, ws_size); grid_blocks = -1; return; }
        int dev = 0, cus = 0, per_cu = 0;
        (void)hipGetDevice(&dev);
        (void)hipDeviceGetAttribute(&cus, hipDeviceAttributeMultiprocessorCount, dev);
        (void)hipFuncSetAttribute((const void*)fwd_kernel, hipFuncAttributeMaxDynamicSharedMemorySize, LDS_BYTES);
        (void)hipOccupancyMaxActiveBlocksPerMultiprocessor(&per_cu, (const void*)fwd_kernel, 512, LDS_BYTES);
        if (per_cu < 1) per_cu = 1;
        grid_blocks = cus * per_cu;
    }
    if (grid_blocks < 0) return;
    Args a{};
    for (int i = 0; i < 12; ++i) a.in[i] = (const float*)d_in[i];
    a.out = (float*)d_out; a.ws = (unsigned char*)d_ws;
    void* args[] = {&a};
    hipError_t e = hipLaunchCooperativeKernel((const void*)fwd_kernel, dim3(grid_blocks), dim3(512), args, LDS_BYTES, stream);
    if (e != hipSuccess) fprintf(stderr, "cooperative launch failed: %s (grid %d)\n", hipGetErrorString(e), grid_blocks);
}
```
